# Optimizing an MI355X kernel written in HIP

```python
import math
import jax, jax.numpy as jnp
from jax import lax
import numpy as np

D_MODEL = 1024
BATCH = 4
SEQ = 8192
DEPTH = 2

HEAD_DIM = 64
N_HEADS_A = 8
N_HEADS_B = 8
D_ATTN = (N_HEADS_A + N_HEADS_B) * HEAD_DIM
D_ATTN_IN = 3 * D_ATTN + N_HEADS_B
MOBA_BLOCK = 256
MOBA_TOPK = 3
MOBA_QCHUNK = 32
FOX_QBLOCK = 128
REL_BUCKETS = 32
REL_MAX_DIST = 128
SGU_CHUNK = 128
SGU_GROUPS = 8
SGU_WIDTH = D_MODEL
D_FF = 2816
PLE_DIM = 256
N_EVEN = (DEPTH + 1) // 2
N_ODD = DEPTH // 2
DN_ALPHA = (2.0 * DEPTH) ** 0.25
DN_BETA = (8.0 * DEPTH) ** -0.25
LN_EPS = 1e-5
NEG_INF = -1e30

kernel_name = "hybrid_moba_fox_gmlp_macaron_deepnorm"


def layer_norm(x, g, b):
    xf = x.astype(jnp.float32)
    mu = jnp.mean(xf, axis=-1, keepdims=True)
    var = jnp.mean(jnp.square(xf - mu), axis=-1, keepdims=True)
    y = (xf - mu) * lax.rsqrt(var + LN_EPS)
    return (y * g.astype(jnp.float32) + b.astype(jnp.float32)).astype(x.dtype)


def swiglu(x, w_gate, w_up, w_down):
    return (jax.nn.silu(x @ w_gate) * (x @ w_up)) @ w_down


def t5_bucket(n):
    n = jnp.maximum(n, 0)
    max_exact = REL_BUCKETS // 2
    nf = jnp.maximum(n, max_exact).astype(jnp.float32)
    large = max_exact + (jnp.log(nf / max_exact) / math.log(REL_MAX_DIST / max_exact)
                         * (REL_BUCKETS - max_exact)).astype(jnp.int32)
    large = jnp.minimum(large, REL_BUCKETS - 1)
    return jnp.where(n < max_exact, n, large)


def moba_attention(q, k, v, rel_bias):
    B, H, S, hd = q.shape
    nb = -(-S // MOBA_BLOCK)
    sp = nb * MOBA_BLOCK
    pad = ((0, 0), (0, 0), (0, sp - S), (0, 0))
    q, k, v = jnp.pad(q, pad), jnp.pad(k, pad), jnp.pad(v, pad)
    kb = k.reshape(B, H, nb, MOBA_BLOCK, hd)
    vb = v.reshape(B, H, nb, MOBA_BLOCK, hd)
    kbar = jnp.mean(kb.astype(jnp.float32), axis=3).astype(k.dtype)
    topk = min(MOBA_TOPK, nb)
    tbl = rel_bias.T.astype(jnp.float32)
    bi = jnp.arange(B)[:, None, None, None]
    hi = jnp.arange(H)[None, :, None, None]
    r = jnp.arange(MOBA_BLOCK)
    scale = hd ** -0.5
    nsel = topk * MOBA_BLOCK

    def chunk(c):
        start = c * MOBA_QCHUNK
        blk = start // MOBA_BLOCK
        qc = lax.dynamic_slice_in_dim(q, start, MOBA_QCHUNK, axis=2)
        t = start + jnp.arange(MOBA_QCHUNK)
        gate = jnp.einsum('bhqd,bhnd->bhqn', qc, kbar).astype(jnp.float32)
        gate = jnp.where(jnp.arange(nb) < blk, gate, NEG_INF)
        _, idx = lax.top_k(gate, topk)
        valid = jnp.arange(topk) < blk
        kg = kb[bi, hi, idx]
        vg = vb[bi, hi, idx]
        s_sel = jnp.einsum('bhqd,bhqkrd->bhqkr', qc, kg).astype(jnp.float32) * scale
        pos_sel = idx[..., None] * MOBA_BLOCK + r
        s_sel = s_sel + tbl[hi[..., None], t5_bucket(t[:, None, None] - pos_sel)]
        s_sel = jnp.where(valid[:, None], s_sel, NEG_INF)
        k_own = lax.dynamic_slice_in_dim(kb, blk, 1, axis=2)[:, :, 0]
        v_own = lax.dynamic_slice_in_dim(vb, blk, 1, axis=2)[:, :, 0]
        rel_own = t[:, None] - (blk * MOBA_BLOCK + r)[None, :]
        s_own = (jnp.einsum('bhqd,bhrd->bhqr', qc, k_own).astype(jnp.float32) * scale
                 + tbl[:, t5_bucket(rel_own)])
        s_own = jnp.where(rel_own >= 0, s_own, NEG_INF)
        logits = jnp.concatenate([s_sel.reshape(B, H, MOBA_QCHUNK, nsel), s_own], axis=-1)
        prob = jax.nn.softmax(logits, axis=-1).astype(v.dtype)
        p_sel = prob[..., :nsel].reshape(B, H, MOBA_QCHUNK, topk, MOBA_BLOCK)
        return (jnp.einsum('bhqkr,bhqkrd->bhqd', p_sel, vg)
                + jnp.einsum('bhqr,bhrd->bhqd', prob[..., nsel:], v_own))

    out = lax.map(chunk, jnp.arange(sp // MOBA_QCHUNK))
    return jnp.moveaxis(out, 0, 2).reshape(B, H, sp, hd)[:, :, :S]


def forgetting_attention(q, k, v, log_f):
    B, H, S, hd = q.shape
    c = jnp.cumsum(log_f, axis=-1)
    scale = hd ** -0.5
    s_pos = jnp.arange(S)

    def block(i):
        start = i * FOX_QBLOCK
        qb = lax.dynamic_slice_in_dim(q, start, FOX_QBLOCK, axis=2)
        cb = lax.dynamic_slice_in_dim(c, start, FOX_QBLOCK, axis=2)
        t = start + jnp.arange(FOX_QBLOCK)
        logits = (jnp.einsum('bhqd,bhsd->bhqs', qb, k).astype(jnp.float32) * scale
                  + (cb[..., None] - c[:, :, None, :]))
        logits = jnp.where(t[:, None] >= s_pos[None, :], logits, NEG_INF)
        prob = jax.nn.softmax(logits, axis=-1).astype(v.dtype)
        return jnp.einsum('bhqs,bhsd->bhqd', prob, v)

    out = lax.map(block, jnp.arange(S // FOX_QBLOCK))
    return jnp.moveaxis(out, 0, 2).reshape(B, H, S, hd)


def mixer_attention(x, w_in, b_f, w_out, rel_bias):
    B, S, _ = x.shape
    h = x @ w_in
    wa = N_HEADS_A * HEAD_DIM
    wb = N_HEADS_B * HEAD_DIM
    qkv_a = h[..., :3 * wa].reshape(B, S, 3, N_HEADS_A, HEAD_DIM).transpose(2, 0, 3, 1, 4)
    qkv_b = h[..., 3 * wa:3 * wa + 3 * wb].reshape(B, S, 3, N_HEADS_B, HEAD_DIM).transpose(2, 0, 3, 1, 4)
    f_logit = (h[..., 3 * wa + 3 * wb:] + b_f).astype(jnp.float32)
    log_f = jax.nn.log_sigmoid(f_logit).transpose(0, 2, 1)
    o_a = moba_attention(qkv_a[0], qkv_a[1], qkv_a[2], rel_bias)
    o_b = forgetting_attention(qkv_b[0], qkv_b[1], qkv_b[2], log_f)
    o = jnp.concatenate([o_a, o_b], axis=1).transpose(0, 2, 1, 3).reshape(B, S, D_ATTN)
    return o @ w_out


def mixer_sgu(x, w_in, b_in, ln_g, ln_b, w_s, b_s, w_out):
    B, S, _ = x.shape
    h = jax.nn.gelu(x @ w_in + b_in)
    u, v = jnp.split(h, 2, axis=-1)
    v = layer_norm(v, ln_g, ln_b)
    nc = S // SGU_CHUNK
    gw = SGU_WIDTH // SGU_GROUPS
    v = v.reshape(B, nc, SGU_CHUNK, SGU_GROUPS, gw)
    causal = jnp.tril(jnp.ones((SGU_CHUNK, SGU_CHUNK), dtype=bool))
    w = jnp.where(causal, w_s, 0)
    mixed = jnp.einsum('gts,bcsgd->bctgd', w, v) + b_s.T[None, None, :, :, None]
    y = u * mixed.reshape(B, S, SGU_WIDTH)
    return y @ w_out


def setup_inputs(seed: int = 0) -> dict:
    key = jax.random.key(seed)
    ks = jax.random.split(key, 20)
    D = D_MODEL

    def nrm(k, shape, s):
        return jax.random.normal(k, shape, jnp.float32) * s

    return {
        "x": nrm(ks[0], (BATCH, SEQ, D), 1.0),
        "p": nrm(ks[1], (DEPTH, BATCH, SEQ, PLE_DIM), 1.0),
        "ln_g": 1.0 + nrm(ks[2], (DEPTH, 3, D), 0.02),
        "ln_b": nrm(ks[3], (DEPTH, 3, D), 0.02),
        "ffn_w_gate": nrm(ks[4], (DEPTH, 2, D, D_FF), D ** -0.5),
        "ffn_w_up": nrm(ks[5], (DEPTH, 2, D, D_FF), D ** -0.5),
        "ffn_w_down": nrm(ks[6], (DEPTH, 2, D_FF, D), DN_BETA * D_FF ** -0.5),
        "attn_w_in": nrm(ks[7], (N_EVEN, D, D_ATTN_IN), D ** -0.5),
        "attn_b_f": jax.random.uniform(ks[8], (N_EVEN, N_HEADS_B), jnp.float32, 2.0, 6.0),
        "attn_w_out": nrm(ks[9], (N_EVEN, D_ATTN, D), DN_BETA * D_ATTN ** -0.5),
        "rel_bias": nrm(ks[10], (REL_BUCKETS, N_HEADS_A), 0.5),
        "sgu_w_in": nrm(ks[11], (N_ODD, D, 2 * SGU_WIDTH), D ** -0.5),
        "sgu_b_in": nrm(ks[12], (N_ODD, 2 * SGU_WIDTH), 0.02),
        "sgu_ln_g": 1.0 + nrm(ks[13], (N_ODD, SGU_WIDTH), 0.02),
        "sgu_ln_b": nrm(ks[14], (N_ODD, SGU_WIDTH), 0.02),
        "sgu_w_s": nrm(ks[15], (N_ODD, SGU_GROUPS, SGU_CHUNK, SGU_CHUNK), SGU_CHUNK ** -0.5),
        "sgu_b_s": 1.0 + nrm(ks[16], (N_ODD, SGU_GROUPS, SGU_CHUNK), 0.1),
        "sgu_w_out": nrm(ks[17], (N_ODD, SGU_WIDTH, D), DN_BETA * SGU_WIDTH ** -0.5),
        "ple_w_proj": nrm(ks[18], (DEPTH, PLE_DIM, D), PLE_DIM ** -0.5),
        "ple_w_gate": nrm(ks[19], (DEPTH, D, D), D ** -0.5),
    }


def reference(x, p, ln_g, ln_b, ffn_w_gate, ffn_w_up, ffn_w_down, attn_w_in, attn_b_f,
              attn_w_out, rel_bias, sgu_w_in, sgu_b_in, sgu_ln_g, sgu_ln_b, sgu_w_s, sgu_b_s,
              sgu_w_out, ple_w_proj, ple_w_gate):
    for i in range(DEPTH):
        j = i // 2
        x = layer_norm(DN_ALPHA * x + 0.5 * swiglu(x, ffn_w_gate[i, 0], ffn_w_up[i, 0], ffn_w_down[i, 0]),
                       ln_g[i, 0], ln_b[i, 0])
        if i % 2 == 0:
            m = mixer_attention(x, attn_w_in[j], attn_b_f[j], attn_w_out[j], rel_bias)
        else:
            m = mixer_sgu(x, sgu_w_in[j], sgu_b_in[j], sgu_ln_g[j], sgu_ln_b[j],
                          sgu_w_s[j], sgu_b_s[j], sgu_w_out[j])
        x = layer_norm(DN_ALPHA * x + m, ln_g[i, 1], ln_b[i, 1])
        x = layer_norm(DN_ALPHA * x + 0.5 * swiglu(x, ffn_w_gate[i, 1], ffn_w_up[i, 1], ffn_w_down[i, 1]),
                       ln_g[i, 2], ln_b[i, 2])
        x = x + jax.nn.sigmoid(x @ ple_w_gate[i]) * (p[i] @ ple_w_proj[i])
    return x
```

```cpp
#include <hip/hip_runtime.h>
#include <cstdio>
#include <cstdint>
__device__ __forceinline__ int lbid() { int b = blockIdx.x; asm volatile("" : "+s"(b)); return b; }
__device__ __forceinline__ int lgrid() { int g = gridDim.x; asm volatile("" : "+s"(g)); return g; }
namespace pg8 {
#define PG8_LAS __attribute__((address_space(3)))
typedef unsigned short bf16_t;
typedef short bf16x8 __attribute__((ext_vector_type(8)));
typedef float f32x4 __attribute__((ext_vector_type(4)));
typedef unsigned u32x4 __attribute__((ext_vector_type(4)));
constexpr int BM = 256, BK = 64, HALF = 128, HTB = HALF * BK * 2  , STAGE_BYTES = 8 * HTB, NXCD = 8, WGM = 4;

__host__ __device__ __forceinline__ int lds_byte(int r, int c) { const int st = (r >> 4) * 2 + (c >> 5), rr = r & 15, cc = c & 31, ob = rr * 64 + cc * 2; return st * 1024 + (ob ^ (((ob >> 9) & 1) << 5)); }
__host__ __device__ __forceinline__ void stage_rc(int b, int& R, int& C) { const int st = b / 1024, sb = b % 1024, swz = sb ^ (((sb >> 9) & 1) << 5); R = (st >> 1) * 16 + swz / 64; C = (st & 1) * 32 + (swz % 64) / 2; }
__host__ __device__ __forceinline__ int perm32(int rho) { const int n = rho >> 4, i = rho & 15; return 8 * (i >> 2) + 4 * n + (i & 3); }

struct Unit { int pm, pn; };
struct Gemm { const bf16_t* A; const bf16_t* Bt; int M, N, K, lda, ldb; long kstepA, kstepB; };

struct StaticOrder {
    int nM, nN, nwg, G, c;
    __host__ __device__ void init(int M, int N, int G_, int c_) { nM = M / BM; nN = N / BM; nwg = nM * nN; G = G_; c = c_; }
    __host__ __device__ bool next(int i, Unit& u) const {
        const long L = (long)i * G + c; if (L >= nwg) return false;
        int wgid = (int)L; { const int q = nwg / NXCD, r = nwg % NXCD, xcd = wgid % NXCD, off = wgid / NXCD; wgid = (xcd < r ? xcd * (q + 1) : r * (q + 1) + (xcd - r) * q) + off; }
        const int nig = WGM * nN, gid = wgid / nig, fm = gid * WGM, gsz = (nM - fm) < WGM ? (nM - fm) : WGM;
        u.pm = fm + ((wgid % nig) % gsz); u.pn = (wgid % nig) / gsz; return true;
    }
    __device__ __forceinline__ void a_ready(const Unit&) const {}
    __device__ __forceinline__ void done(const Unit&) const {}
};

__device__ __forceinline__ unsigned cvt_pk_bf16(float lo, float hi) { unsigned r; asm("v_cvt_pk_bf16_f32 %0, %1, %2" : "=v"(r) : "v"(lo), "v"(hi)); return r; }
typedef float f32x2 __attribute__((ext_vector_type(2)));
__device__ __forceinline__ f32x2 gelu_pk(f32x2 v) {
    const f32x2 av = __builtin_elementwise_abs(v), d = av * 0.2316418882f + 1.0f;
    f32x2 t; t.x = __builtin_amdgcn_rcpf(d.x); t.y = __builtin_amdgcn_rcpf(d.y);
    f32x2 q = t * 0.5307027145f + (-0.7265760135f); q = q * t + 0.7107068705f; q = q * t + (-0.142248368f); q = q * t + 0.127414796f; q = q * t;
    const f32x2 s = (v * v) * (-0.72134752044f);
    f32x2 e; e.x = __builtin_amdgcn_exp2f(s.x); e.y = __builtin_amdgcn_exp2f(s.y);
    const f32x2 m = v * (q * e), r = v - m;
    f32x2 o; o.x = v.x < 0.f ? m.x : r.x; o.y = v.y < 0.f ? m.y : r.y; return o;
}

template <int ACT  > struct EpiBf16 {
    static constexpr bool PERM = true, AFTER_DRAIN = false; static_assert(ACT == 0 || ACT == 1, "EpiBf16: ACT is 0 (none) or 1 (gelu_pk)");
    bf16_t* O; int ldc; const float* bias; int split_cols; size_t split_stride; float scale0;
    __device__ __forceinline__ void operator()(const f32x4 (&acc)[2][2][4][2], const Unit& u, int wr, int wc, int fr_in, int fq_in) const {
        int fr = fr_in, fq = fq_in; asm volatile("" : "+v"(fr), "+v"(fq));
        const int row0 = u.pm * BM + wr * 64 + fr; int colt = u.pn * BM; bf16_t* base = O;
        float sc = 1.f; if (split_cols) { const int t = colt / split_cols; base += (size_t)t * split_stride; colt -= t * split_cols; if (t == 0) sc = scale0; }
        const int col0 = colt + wc * 32 + 8 * fq, bcol0 = u.pn * BM + wc * 32 + 8 * fq;
        f32x4 bv[2][2];
#pragma unroll
        for (int bj = 0; bj < 2; ++bj)
#pragma unroll
            for (int n = 0; n < 2; ++n) bv[bj][n] = bias ? *(const f32x4*)(bias + bcol0 + bj * HALF + 4 * n) : (f32x4){0.f, 0.f, 0.f, 0.f};
#pragma unroll
        for (int ai = 0; ai < 2; ++ai)
#pragma unroll
            for (int m = 0; m < 4; ++m) { bf16_t* rowp = base + (size_t)(row0 + ai * HALF + m * 16) * ldc + col0;
#pragma unroll
                for (int bj = 0; bj < 2; ++bj) { f32x4 v0 = acc[ai][bj][m][0] + bv[bj][0], v1 = acc[ai][bj][m][1] + bv[bj][1];
                    if (ACT == 1) { f32x2 a = gelu_pk((f32x2){v0[0], v0[1]}), b = gelu_pk((f32x2){v0[2], v0[3]}), c = gelu_pk((f32x2){v1[0], v1[1]}), d = gelu_pk((f32x2){v1[2], v1[3]});
                        v0 = (f32x4){a.x, a.y, b.x, b.y}; v1 = (f32x4){c.x, c.y, d.x, d.y}; }
                    v0 = v0 * sc; v1 = v1 * sc; u32x4 w; w.x = cvt_pk_bf16(v0[0], v0[1]); w.y = cvt_pk_bf16(v0[2], v0[3]); w.z = cvt_pk_bf16(v1[0], v1[1]); w.w = cvt_pk_bf16(v1[2], v1[3]);
                    *(u32x4*)(rowp + bj * HALF) = w; } }
    }
};
__device__ __forceinline__ float fast_sigmoid(float v) { return __builtin_amdgcn_rcpf(1.0f + __builtin_amdgcn_exp2f(-1.4426950408889634f * v)); }
__device__ __forceinline__ float gelu_tanh(float v) { const float u = 0.7978845608028654f * (v + 0.044715f * v * v * v); return v * fast_sigmoid(2.0f * u); }
struct RowStats { float mu[2][4], rs[2][4]; };
__device__ __forceinline__ void load_row_stats(const float* sp, int row0, RowStats& r) {
#pragma unroll
    for (int ai = 0; ai < 2; ++ai) { asm volatile("" ::: "memory");
#pragma unroll
        for (int m = 0; m < 4; ++m) { const float* p = sp + (size_t)(row0 + ai * HALF + m * 16) * 8; const f32x4 a = *(const f32x4*)p, b = *(const f32x4*)(p + 4);
            const float s1 = (a[0] + a[2]) + (b[0] + b[2]), s2 = (a[1] + a[3]) + (b[1] + b[3]); const float mu = s1 * (1.f / 1024.f); const float var = s2 * (1.f / 1024.f) - mu * mu;
            r.mu[ai][m] = mu; r.rs[ai][m] = __builtin_amdgcn_rsqf(__builtin_fmaxf(var, 0.f) + 1e-5f); } }
}
__device__ __forceinline__ f32x4 ln_fix(const f32x4& a, float mu, float rs, const f32x4& cs, const f32x4& cb) { return (a - cs * mu) * rs + cb; }
__device__ __forceinline__ void emit_row_stats(float (&s1)[2][4], float (&s2)[2][4], float* sp_new, const Unit& u, int wr, int wc, int fr, int fq, PG8_LAS unsigned char* xl) {
    typedef float f32x2v __attribute__((ext_vector_type(2)));
    PG8_LAS f32x2v* P = (PG8_LAS f32x2v*)xl;
#pragma unroll
    for (int ai = 0; ai < 2; ++ai)
#pragma unroll
        for (int m = 0; m < 4; ++m) { float a = s1[ai][m], b = s2[ai][m]; a += __shfl_xor(a, 16); b += __shfl_xor(b, 16); a += __shfl_xor(a, 32); b += __shfl_xor(b, 32);
            if (fq == 0) P[(ai * HALF + wr * 64 + m * 16 + fr) * 4 + wc] = (f32x2v){a, b}; }
    asm volatile("s_waitcnt lgkmcnt(0)" ::: "memory"); __builtin_amdgcn_s_barrier(); asm volatile("" ::: "memory");
    const int tid = (wr * 4 + wc) * 64 + fq * 16 + fr;
    if (tid < 256) { const f32x2v a = P[tid * 4 + 0], b = P[tid * 4 + 1], c = P[tid * 4 + 2], d = P[tid * 4 + 3];
        f32x2v o; o.x = (a.x + b.x) + (c.x + d.x); o.y = (a.y + b.y) + (c.y + d.y);
        *(f32x2v*)(sp_new + ((size_t)(u.pm * BM + tid) * 4 + u.pn) * 2) = o; }
    asm volatile("s_waitcnt lgkmcnt(0)" ::: "memory"); __builtin_amdgcn_s_barrier(); asm volatile("" ::: "memory");
}
template <bool LN> struct EpiSwiglu {
    static constexpr bool PERM = true, AFTER_DRAIN = false;
    bf16_t* H; int mrows; const float* sp; const float* cs; const float* cb;
    __device__ __forceinline__ void operator()(const f32x4 (&acc)[2][2][4][2], const Unit& u, int wr, int wc, int fr_in, int fq_in) const {
        int fr = fr_in, fq = fq_in; asm volatile("" : "+v"(fr), "+v"(fq));
        const int row0 = u.pm * BM + wr * 64 + fr, n0 = u.pn * BM + wc * 32 + 8 * fq; const int kt = u.pn * 2 + (wc >> 1), cin = (wc & 1) * 32 + 8 * fq;
        RowStats rst; f32x4 csv[2][2], cbv[2][2];
        if constexpr (LN) { load_row_stats(sp, row0, rst);
#pragma unroll
            for (int bj = 0; bj < 2; ++bj)
#pragma unroll
                for (int n = 0; n < 2; ++n) { csv[bj][n] = *(const f32x4*)(cs + n0 + bj * HALF + 4 * n); cbv[bj][n] = *(const f32x4*)(cb + n0 + bj * HALF + 4 * n); } }
#pragma unroll
        for (int ai = 0; ai < 2; ++ai)
#pragma unroll
            for (int m = 0; m < 4; ++m) { bf16_t* rowp = H + ((size_t)kt * mrows + (row0 + ai * HALF + m * 16)) * 64 + cin;
                float h[8];
#pragma unroll
                for (int n = 0; n < 2; ++n) { f32x4 g = acc[ai][0][m][n], uu = acc[ai][1][m][n];
                    if constexpr (LN) { g = ln_fix(g, rst.mu[ai][m], rst.rs[ai][m], csv[0][n], cbv[0][n]); uu = ln_fix(uu, rst.mu[ai][m], rst.rs[ai][m], csv[1][n], cbv[1][n]); }
#pragma unroll
                    for (int j = 0; j < 4; ++j) h[4 * n + j] = g[j] * fast_sigmoid(g[j]) * uu[j]; }
                u32x4 w; w.x = cvt_pk_bf16(h[0], h[1]); w.y = cvt_pk_bf16(h[2], h[3]); w.z = cvt_pk_bf16(h[4], h[5]); w.w = cvt_pk_bf16(h[6], h[7]);
                *(u32x4*)rowp = w; }
    }
};
__device__ __forceinline__ float bf_lo(unsigned w) { return __uint_as_float(w << 16); }
__device__ __forceinline__ float bf_hi(unsigned w) { return __uint_as_float(w & 0xffff0000u); }
template <int BASE> struct EpiResid {
    static constexpr bool PERM = true, AFTER_DRAIN = false;
    const float* basef; const bf16_t* baseb; bf16_t* zb; float alpha, s; const float* sp_old; const float* lg; const float* lb; float* sp_new; PG8_LAS unsigned char* xl;
    __device__ __forceinline__ void operator()(const f32x4 (&acc)[2][2][4][2], const Unit& u, int wr, int wc, int fr_in, int fq_in) const {
        int fr = fr_in, fq = fq_in; asm volatile("" : "+v"(fr), "+v"(fq));
        const int row0 = u.pm * BM + wr * 64 + fr, col0 = u.pn * BM + wc * 32 + 8 * fq;
        float al_ = alpha, s_ = s; asm volatile("" : "+v"(al_), "+v"(s_));
        RowStats rst;
        if constexpr (BASE == 1) load_row_stats(sp_old, row0, rst);
        float s1[2][4], s2[2][4];
#pragma unroll
        for (int ai = 0; ai < 2; ++ai)
#pragma unroll
            for (int m = 0; m < 4; ++m) { s1[ai][m] = 0.f; s2[ai][m] = 0.f; }
#pragma unroll
        for (int bj = 0; bj < 2; ++bj) { f32x4 gv[2], bv[2];
            if constexpr (BASE == 1) {
#pragma unroll
                for (int n = 0; n < 2; ++n) { gv[n] = *(const f32x4*)(lg + col0 + bj * HALF + 4 * n); bv[n] = *(const f32x4*)(lb + col0 + bj * HALF + 4 * n); } }
#pragma unroll
            for (int ai = 0; ai < 2; ++ai) {
                f32x4 pf[4][2]; u32x4 pb[4];
#pragma unroll
                for (int m = 0; m < 4; ++m) { const size_t off = (size_t)(row0 + ai * HALF + m * 16) * 1024 + col0 + bj * HALF;
                    if constexpr (BASE == 0) { pf[m][0] = *(const f32x4*)(basef + off); pf[m][1] = *(const f32x4*)(basef + off + 4); } else pb[m] = *(const u32x4*)(baseb + off); }
#pragma unroll
                for (int m = 0; m < 4; ++m) { const size_t off = (size_t)(row0 + ai * HALF + m * 16) * 1024 + col0 + bj * HALF; f32x4 b[2];
                    if constexpr (BASE == 0) { b[0] = pf[m][0]; b[1] = pf[m][1]; }
                    else { const u32x4 pw = pb[m]; b[0] = (f32x4){bf_lo(pw.x), bf_hi(pw.x), bf_lo(pw.y), bf_hi(pw.y)}; b[1] = (f32x4){bf_lo(pw.z), bf_hi(pw.z), bf_lo(pw.w), bf_hi(pw.w)}; }
                    f32x4 z[2];
#pragma unroll
                    for (int n = 0; n < 2; ++n) { if constexpr (BASE == 1) b[n] = (b[n] - rst.mu[ai][m]) * rst.rs[ai][m] * gv[n] + bv[n];
                        z[n] = b[n] * al_ + acc[ai][bj][m][n] * s_; }
                    u32x4 w; w.x = cvt_pk_bf16(z[0][0], z[0][1]); w.y = cvt_pk_bf16(z[0][2], z[0][3]); w.z = cvt_pk_bf16(z[1][0], z[1][1]); w.w = cvt_pk_bf16(z[1][2], z[1][3]);
                    *(u32x4*)(zb + off) = w;
                    const float r0 = bf_lo(w.x), r1 = bf_hi(w.x), r2 = bf_lo(w.y), r3 = bf_hi(w.y), r4 = bf_lo(w.z), r5 = bf_hi(w.z), r6 = bf_lo(w.w), r7 = bf_hi(w.w);
                    s1[ai][m] += ((r0 + r1) + (r2 + r3)) + ((r4 + r5) + (r6 + r7)); s2[ai][m] += ((r0 * r0 + r1 * r1) + (r2 * r2 + r3 * r3)) + ((r4 * r4 + r5 * r5) + (r6 * r6 + r7 * r7)); }
                asm volatile("" ::: "memory"); } }
        emit_row_stats(s1, s2, sp_new, u, wr, wc, fr, fq, xl);
    }
};
struct EpiQKV {
    static constexpr bool PERM = true, AFTER_DRAIN = false;
    bf16_t* O; size_t split_stride; float scale0; float* kbar; const float* sp; const float* cs; const float* cb;
    __device__ __forceinline__ void operator()(const f32x4 (&acc)[2][2][4][2], const Unit& u, int wr, int wc, int fr_in, int fq_in) const {
        int fr = fr_in, fq = fq_in; asm volatile("" : "+v"(fr), "+v"(fq));
        const int row0 = u.pm * BM + wr * 64 + fr; const int t = u.pn >> 2; bf16_t* base = O + (size_t)t * split_stride; const float sc = (t == 0) ? scale0 : 1.f;
        const int col0 = (u.pn & 3) * BM + wc * 32 + 8 * fq, n0 = u.pn * BM + wc * 32 + 8 * fq;
        RowStats rst; load_row_stats(sp, row0, rst); f32x4 csv[2][2], cbv[2][2];
#pragma unroll
        for (int bj = 0; bj < 2; ++bj)
#pragma unroll
            for (int n = 0; n < 2; ++n) { csv[bj][n] = *(const f32x4*)(cs + n0 + bj * HALF + 4 * n); cbv[bj][n] = *(const f32x4*)(cb + n0 + bj * HALF + 4 * n); }
        const bool kb = (u.pn == 4 || u.pn == 5);
        f32x4 ks[2][2];
#pragma unroll
        for (int bj = 0; bj < 2; ++bj)
#pragma unroll
            for (int n = 0; n < 2; ++n) ks[bj][n] = (f32x4){0.f, 0.f, 0.f, 0.f};
#pragma unroll
        for (int ai = 0; ai < 2; ++ai)
#pragma unroll
            for (int m = 0; m < 4; ++m) { bf16_t* rowp = base + (size_t)(row0 + ai * HALF + m * 16) * 1024 + col0;
#pragma unroll
                for (int bj = 0; bj < 2; ++bj) { const f32x4 v0r = ln_fix(acc[ai][bj][m][0], rst.mu[ai][m], rst.rs[ai][m], csv[bj][0], cbv[bj][0]), v1r = ln_fix(acc[ai][bj][m][1], rst.mu[ai][m], rst.rs[ai][m], csv[bj][1], cbv[bj][1]);
                    ks[bj][0] += v0r; ks[bj][1] += v1r; const f32x4 v0 = v0r * sc, v1 = v1r * sc;
                    u32x4 w; w.x = cvt_pk_bf16(v0[0], v0[1]); w.y = cvt_pk_bf16(v0[2], v0[3]); w.z = cvt_pk_bf16(v1[0], v1[1]); w.w = cvt_pk_bf16(v1[2], v1[3]);
                    *(u32x4*)(rowp + bj * HALF) = w; } }
        if (kb) {
            const int colt = (u.pn - 4) * BM + wc * 32 + 8 * fq; const int b = u.pm >> 5, blk = u.pm & 31;
#pragma unroll
            for (int bj = 0; bj < 2; ++bj)
#pragma unroll
                for (int n = 0; n < 2; ++n)
#pragma unroll
                    for (int j = 0; j < 4; ++j) { float s = ks[bj][n][j];
                        s += __shfl_xor(s, 1); s += __shfl_xor(s, 2); s += __shfl_xor(s, 4); s += __shfl_xor(s, 8);
                        if (fr == 0) { const int col = colt + bj * HALF + 4 * n + j; atomicAdd(kbar + ((size_t)((b * 8 + (col >> 6)) * 32 + blk)) * 64 + (col & 63), s); } }
        }
    }
};
struct EpiSguIn {
    static constexpr bool PERM = true, AFTER_DRAIN = false;
    bf16_t* U; bf16_t* V; const float* bias; const float* sp; const float* cs; const float* cb; float* spv; PG8_LAS unsigned char* xl;
    __device__ __forceinline__ void operator()(const f32x4 (&acc)[2][2][4][2], const Unit& u, int wr, int wc, int fr_in, int fq_in) const {
        int fr = fr_in, fq = fq_in; asm volatile("" : "+v"(fr), "+v"(fq));
        const int row0 = u.pm * BM + wr * 64 + fr; const int t = u.pn >> 2; bf16_t* base = t ? V : U;
        const int col0 = (u.pn & 3) * BM + wc * 32 + 8 * fq, n0 = u.pn * BM + wc * 32 + 8 * fq;
        RowStats rst; load_row_stats(sp, row0, rst);
#pragma unroll
        for (int bj = 0; bj < 2; ++bj) { f32x4 csv[2], cbv[2];
#pragma unroll
            for (int n = 0; n < 2; ++n) { csv[n] = *(const f32x4*)(cs + n0 + bj * HALF + 4 * n); cbv[n] = *(const f32x4*)(cb + n0 + bj * HALF + 4 * n) + *(const f32x4*)(bias + n0 + bj * HALF + 4 * n); }
#pragma unroll
            for (int ai = 0; ai < 2; ++ai)
#pragma unroll
                for (int m = 0; m < 4; ++m) { bf16_t* rowp = base + (size_t)(row0 + ai * HALF + m * 16) * 1024 + col0 + bj * HALF;
                    f32x4 v0 = ln_fix(acc[ai][bj][m][0], rst.mu[ai][m], rst.rs[ai][m], csv[0], cbv[0]), v1 = ln_fix(acc[ai][bj][m][1], rst.mu[ai][m], rst.rs[ai][m], csv[1], cbv[1]);
#pragma unroll
                    for (int j = 0; j < 4; ++j) { v0[j] = gelu_tanh(v0[j]); v1[j] = gelu_tanh(v1[j]); }
                    u32x4 w; w.x = cvt_pk_bf16(v0[0], v0[1]); w.y = cvt_pk_bf16(v0[2], v0[3]); w.z = cvt_pk_bf16(v1[0], v1[1]); w.w = cvt_pk_bf16(v1[2], v1[3]);
                    *(u32x4*)rowp = w; } }
    }
};
template <bool FINAL> struct EpiPle {
    static constexpr bool PERM = true, AFTER_DRAIN = false;
    const bf16_t* zb; float* outf; bf16_t* pexb; const float* sp; const float* cs; const float* cb; const float* lg; const float* lb;
    __device__ __forceinline__ void operator()(const f32x4 (&acc)[2][2][4][2], const Unit& u, int wr, int wc, int fr_in, int fq_in) const {
        int fr = fr_in, fq = fq_in; asm volatile("" : "+v"(fr), "+v"(fq));
        const int row0 = u.pm * BM + wr * 64 + fr, col0 = u.pn * BM + wc * 32 + 8 * fq;
        RowStats rst; load_row_stats(sp, row0, rst);
#pragma unroll
        for (int bj = 0; bj < 2; ++bj) { f32x4 csv[2], cbv[2], gv[2], bv[2];
#pragma unroll
            for (int n = 0; n < 2; ++n) { csv[n] = *(const f32x4*)(cs + col0 + bj * HALF + 4 * n); cbv[n] = *(const f32x4*)(cb + col0 + bj * HALF + 4 * n); gv[n] = *(const f32x4*)(lg + col0 + bj * HALF + 4 * n); bv[n] = *(const f32x4*)(lb + col0 + bj * HALF + 4 * n); }
#pragma unroll
            for (int am = 0; am < (FINAL ? 8 : 4); ++am) { constexpr int GR = FINAL ? 1 : 2; const int ai = (am * GR) >> 2; u32x4 ppw[4], pzw[4];
#pragma unroll
                for (int m = (am * GR) & 3; m < ((am * GR) & 3) + GR; ++m) { const size_t off = (size_t)(row0 + ai * HALF + m * 16) * 1024 + col0 + bj * HALF; ppw[m] = *(const u32x4*)(pexb + off); pzw[m] = *(const u32x4*)(zb + off); }
                asm volatile("" ::: "memory");
#pragma unroll
                for (int m = (am * GR) & 3; m < ((am * GR) & 3) + GR; ++m) { const size_t off = (size_t)(row0 + ai * HALF + m * 16) * 1024 + col0 + bj * HALF; const float mu = rst.mu[ai][m], rs = rst.rs[ai][m];
                    const u32x4 pw = ppw[m]; const u32x4 zw = pzw[m];
                    const f32x4 x0 = ((f32x4){bf_lo(zw.x), bf_hi(zw.x), bf_lo(zw.y), bf_hi(zw.y)} - mu) * rs * gv[0] + bv[0], x1 = ((f32x4){bf_lo(zw.z), bf_hi(zw.z), bf_lo(zw.w), bf_hi(zw.w)} - mu) * rs * gv[1] + bv[1];
                    const f32x4 a0 = ln_fix(acc[ai][bj][m][0], mu, rs, csv[0], cbv[0]), a1 = ln_fix(acc[ai][bj][m][1], mu, rs, csv[1], cbv[1]); f32x4 o0, o1;
                    o0[0] = x0[0] + fast_sigmoid(a0[0]) * bf_lo(pw.x); o0[1] = x0[1] + fast_sigmoid(a0[1]) * bf_hi(pw.x);
                    o0[2] = x0[2] + fast_sigmoid(a0[2]) * bf_lo(pw.y); o0[3] = x0[3] + fast_sigmoid(a0[3]) * bf_hi(pw.y);
                    o1[0] = x1[0] + fast_sigmoid(a1[0]) * bf_lo(pw.z); o1[1] = x1[1] + fast_sigmoid(a1[1]) * bf_hi(pw.z);
                    o1[2] = x1[2] + fast_sigmoid(a1[2]) * bf_lo(pw.w); o1[3] = x1[3] + fast_sigmoid(a1[3]) * bf_hi(pw.w);
                    if constexpr (FINAL) { *(f32x4*)(outf + off) = o0; *(f32x4*)(outf + off + 4) = o1; }
                    else { u32x4 w; w.x = cvt_pk_bf16(o0[0], o0[1]); w.y = cvt_pk_bf16(o0[2], o0[3]); w.z = cvt_pk_bf16(o1[0], o1[1]); w.w = cvt_pk_bf16(o1[2], o1[3]); *(u32x4*)(pexb + off) = w; } } } }
    }
};
template <class Epi, class Sched, bool ALIGN_EPI = false, bool SP2 = false>
__device__ __forceinline__ void gemm_phase(PG8_LAS unsigned char* lds, const Gemm g, const Sched& S, const Epi& E) {
    int tid = threadIdx.x; asm volatile("" : "+v"(tid));
    const int wid = __builtin_amdgcn_readfirstlane(tid >> 6), lane = tid & 63, wr = wid >> 2, wc = wid & 3, fr = lane & 15, fq = lane >> 4;
    int K = g.K; asm volatile("" : "+s"(K)); const int nt = K / BK; const int lda = g.lda, ldb = g.ldb;
    unsigned voffA[2], voffB[2];
#pragma unroll
    for (int i = 0; i < 2; ++i) { int R, C; stage_rc(tid * 16 + i * 8192, R, C); const int Rb = Epi::PERM ? ((R & ~31) + perm32(R & 31)) : R;
        voffA[i] = (unsigned)(R * lda + C) * 2u; voffB[i] = (unsigned)(Rb * ldb + C) * 2u; }
    const long kstep = g.kstepB; const long kstepA = g.kstepA;
    const size_t hstepA = (size_t)HALF * lda * 2, hstepB = (size_t)HALF * ldb * 2;
    const size_t tstepA = 2 * hstepA, tstepB = 2 * hstepB;
    const unsigned ldsw = (unsigned)wid * 1024u;
    const int aoff = lds_byte(wr * 64 + fr, fq * 8), boff = lds_byte(wc * 32 + fr, fq * 8);
#define PG8_SA(b, h) (((b) * 2 + (h)) * HTB)
#define PG8_SB(b, h) ((4 + (b) * 2 + (h)) * HTB)
#define PG8_STAGE(bufoff, gbase, voff) do { _Pragma("unroll") for (int _i = 0; _i < 2; ++_i) \
        __builtin_amdgcn_global_load_lds((const unsigned*)((const char*)(gbase) + (voff)[_i]), (PG8_LAS unsigned*)(lds + (bufoff) + ldsw + _i * 8192), 16, 0, 0); } while (0)
#define PG8_LDA(dst, b, h) do { _Pragma("unroll") for (int m = 0; m < 4; ++m) _Pragma("unroll") for (int k = 0; k < 2; ++k) dst[m][k] = *(const PG8_LAS bf16x8*)(lds + PG8_SA(b, h) + aoff + m * 2048 + k * 1024); } while (0)
#define PG8_LDB(dst, b, h) do { _Pragma("unroll") for (int n = 0; n < 2; ++n) _Pragma("unroll") for (int k = 0; k < 2; ++k) dst[n][k] = *(const PG8_LAS bf16x8*)(lds + PG8_SB(b, h) + boff + n * 2048 + k * 1024); } while (0)
#define PG8_MMA(ai, bj, At, Bt) do { __builtin_amdgcn_s_setprio(1); _Pragma("unroll") for (int m = 0; m < 4; ++m) _Pragma("unroll") for (int n = 0; n < 2; ++n) _Pragma("unroll") for (int k = 0; k < 2; ++k) \
        acc[ai][bj][m][n] = __builtin_amdgcn_mfma_f32_16x16x32_bf16(Bt[n][k], At[m][k], acc[ai][bj][m][n], 0, 0, 0); __builtin_amdgcn_s_setprio(0); } while (0)
#define PG8_WAIT_V(n) asm volatile("s_waitcnt vmcnt(" #n ")" ::: "memory")
#define PG8_WAIT_L(n) asm volatile("s_waitcnt lgkmcnt(" #n ")" ::: "memory")
#define PG8_BAR __builtin_amdgcn_s_barrier()
#define PG8_SCHED __builtin_amdgcn_sched_barrier(0)
    Unit cur, nxt; int ui = 0;
    if (!S.next(0, cur)) return;
    f32x4 acc[2][2][4][2];
#pragma unroll
    for (int a = 0; a < 2; ++a)
#pragma unroll
        for (int b = 0; b < 2; ++b)
#pragma unroll
            for (int m = 0; m < 4; ++m)
#pragma unroll
                for (int n = 0; n < 2; ++n) acc[a][b][m][n] = (f32x4){0.f, 0.f, 0.f, 0.f};
    bf16x8 At[4][2], B0[2][2], B1[2][2];
    const char* cA = (const char*)g.A + (size_t)cur.pm * tstepA; const char* cB = (const char*)g.Bt + (size_t)cur.pn * tstepB;
    S.a_ready(cur);
    if constexpr (SP2) {
        PG8_STAGE(PG8_SB(0, 0), cB, voffB); PG8_STAGE(PG8_SB(0, 1), cB + hstepB, voffB); PG8_STAGE(PG8_SA(0, 0), cA, voffA); PG8_STAGE(PG8_SA(0, 1), cA + hstepA, voffA);
        if (wr == 1) PG8_BAR;
        PG8_WAIT_V(2); PG8_BAR;
        PG8_STAGE(PG8_SB(1, 0), cB + kstep, voffB); PG8_STAGE(PG8_SA(1, 0), cA + kstepA, voffA); PG8_STAGE(PG8_SB(1, 1), cB + hstepB + kstep, voffB);
        PG8_WAIT_V(6); PG8_BAR;
    } else {
        PG8_STAGE(PG8_SB(0, 0), cB, voffB); PG8_STAGE(PG8_SA(0, 0), cA, voffA); PG8_STAGE(PG8_SB(0, 1), cB + hstepB, voffB); PG8_STAGE(PG8_SA(0, 1), cA + hstepA, voffA);
        if (wr == 1) PG8_BAR;
        PG8_WAIT_V(4); PG8_BAR;
        PG8_STAGE(PG8_SB(1, 0), cB + kstep, voffB); PG8_STAGE(PG8_SA(1, 0), cA + kstepA, voffA); PG8_STAGE(PG8_SB(1, 1), cB + hstepB + kstep, voffB);
        PG8_WAIT_V(6); PG8_BAR;
    }
    for (;;) {
        const bool has_next = S.next(ui + 1, nxt);
        const char* nA = has_next ? (const char*)g.A + (size_t)nxt.pm * tstepA : cA; const char* nB = has_next ? (const char*)g.Bt + (size_t)nxt.pn * tstepB : cB;
        for (int t = 0; t < nt; t += 2) {
            const bool last = (t == nt - 2);
            const char* a1 = cA + (long)(t + 1) * kstepA;
            const char* a2 = last ? nA : cA + (long)(t + 2) * kstepA; const char* b2 = last ? nB : cB + (long)(t + 2) * kstep;
            const char* a3 = a2 + kstepA; const char* b3 = b2 + kstep;
            if (last && has_next) S.a_ready(nxt);
            if constexpr (SP2) {
            PG8_LDB(B0, 0, 0); PG8_LDB(B1, 0, 1); PG8_SCHED; PG8_LDA(At, 0, 0); PG8_STAGE(PG8_SA(1, 1), a1 + hstepA, voffA);
            PG8_WAIT_V(8); PG8_WAIT_L(0); PG8_BAR; PG8_MMA(0, 0, At, B0); PG8_MMA(0, 1, At, B1); PG8_BAR; PG8_SCHED;
            PG8_LDA(At, 0, 1); PG8_STAGE(PG8_SB(0, 0), b2, voffB); PG8_STAGE(PG8_SB(0, 1), b2 + hstepB, voffB); PG8_STAGE(PG8_SA(0, 0), a2, voffA);
            PG8_WAIT_V(8); PG8_WAIT_L(0); PG8_BAR; PG8_MMA(1, 0, At, B0); PG8_MMA(1, 1, At, B1); PG8_BAR; PG8_SCHED;
            PG8_LDB(B0, 1, 0); PG8_LDB(B1, 1, 1); PG8_SCHED; PG8_LDA(At, 1, 0); PG8_STAGE(PG8_SA(0, 1), a2 + hstepA, voffA);
            PG8_WAIT_V(8); PG8_WAIT_L(0); PG8_BAR; PG8_MMA(0, 0, At, B0); PG8_MMA(0, 1, At, B1); PG8_BAR; PG8_SCHED;
            PG8_LDA(At, 1, 1); PG8_STAGE(PG8_SB(1, 0), b3, voffB); PG8_STAGE(PG8_SB(1, 1), b3 + hstepB, voffB); PG8_STAGE(PG8_SA(1, 0), a3, voffA);
            PG8_WAIT_V(8); PG8_WAIT_L(0); PG8_BAR; PG8_MMA(1, 0, At, B0); PG8_MMA(1, 1, At, B1); PG8_BAR; PG8_SCHED;
            } else {
            PG8_LDB(B0, 0, 0); PG8_SCHED; PG8_LDA(At, 0, 0); PG8_STAGE(PG8_SA(1, 1), a1 + hstepA, voffA);
            PG8_WAIT_L(8); PG8_BAR; PG8_WAIT_L(0); PG8_MMA(0, 0, At, B0); PG8_BAR; PG8_SCHED;
            PG8_LDB(B1, 0, 1); PG8_STAGE(PG8_SB(0, 0), b2, voffB);
            PG8_BAR; PG8_WAIT_L(0); PG8_MMA(0, 1, At, B1); PG8_BAR;
            PG8_LDA(At, 0, 1); PG8_STAGE(PG8_SA(0, 0), a2, voffA);
            PG8_BAR; PG8_WAIT_L(0); PG8_MMA(1, 0, At, B0); PG8_BAR; PG8_SCHED;
            PG8_STAGE(PG8_SB(0, 1), b2 + hstepB, voffB);
            PG8_WAIT_V(6); PG8_BAR; PG8_MMA(1, 1, At, B1); PG8_BAR;
            PG8_LDB(B0, 1, 0); PG8_SCHED; PG8_LDA(At, 1, 0); PG8_STAGE(PG8_SA(0, 1), a2 + hstepA, voffA);
            PG8_WAIT_L(8); PG8_BAR; PG8_WAIT_L(0); PG8_MMA(0, 0, At, B0); PG8_BAR; PG8_SCHED;
            PG8_LDB(B1, 1, 1); PG8_STAGE(PG8_SB(1, 0), b3, voffB);
            PG8_BAR; PG8_WAIT_L(0); PG8_MMA(0, 1, At, B1); PG8_BAR;
            PG8_LDA(At, 1, 1); PG8_STAGE(PG8_SA(1, 0), a3, voffA);
            PG8_BAR; PG8_WAIT_L(0); PG8_MMA(1, 0, At, B0); PG8_BAR; PG8_SCHED;
            PG8_STAGE(PG8_SB(1, 1), b3 + hstepB, voffB);
            PG8_WAIT_V(6); PG8_BAR; PG8_MMA(1, 1, At, B1); PG8_BAR;
            }
        }
        if constexpr (ALIGN_EPI) { if (wr == 0) PG8_BAR; }
        if constexpr (!Epi::AFTER_DRAIN) { E(acc, cur, wr, wc, fr, fq); S.done(cur); }
        if (!has_next) break;
#pragma unroll
        for (int a = 0; a < 2; ++a)
#pragma unroll
            for (int b = 0; b < 2; ++b)
#pragma unroll
                for (int m = 0; m < 4; ++m)
#pragma unroll
                    for (int n = 0; n < 2; ++n) acc[a][b][m][n] = (f32x4){0.f, 0.f, 0.f, 0.f};
        cur = nxt; cA = nA; cB = nB; ++ui;
        if constexpr (ALIGN_EPI) { if (wr == 1) PG8_BAR; }
    }
    PG8_WAIT_V(0);
    if constexpr (!ALIGN_EPI) { if (wr == 0) PG8_BAR; }
    PG8_BAR;
    if constexpr (Epi::AFTER_DRAIN) { E.fused(acc, cur, wr, wc, fr, fq, lds, wid, lane); S.done(cur); }
#undef PG8_SA
#undef PG8_SB
#undef PG8_STAGE
#undef PG8_LDA
#undef PG8_LDB
#undef PG8_MMA
#undef PG8_WAIT_V
#undef PG8_WAIT_L
#undef PG8_BAR
#undef PG8_SCHED
}
}
#include <hip/hip_bf16.h>
#include <cmath>
namespace attn_body {
using bf16=__hip_bfloat16;
using bf16x8=__attribute__((ext_vector_type(8)))short;
using s16x4=__attribute__((ext_vector_type(4)))short;
using f32x16=__attribute__((ext_vector_type(16)))float;
using u32x4=__attribute__((ext_vector_type(4)))unsigned;
using f32x4v=__attribute__((ext_vector_type(4)))float;
constexpr int BATCH=4,NHEAD=16,SEQ=8192,D=64,DM=NHEAD*D;
constexpr int NW=8,QBLK=32,QB=QBLK*NW,KVBLK=64,NQB=SEQ/QB;
constexpr int ATTN_PITCH=DM, ATTN_UNIT_ROWS=QB;
__device__ __forceinline__ int crow(int r,int hi){return (r&3)+8*(r>>2)+4*hi;}
#define SBAR() __builtin_amdgcn_sched_barrier(0)
__device__ __forceinline__ void cmask(f32x16&p0,f32x16&p1,int jb,int qrel,int hi){
  const float NEG=-INFINITY; int kb=64*jb+4*hi;
  #pragma unroll
  for(int r=0;r<16;++r){int kv=kb+(r&3)+8*(r>>2); if(kv>qrel)p0[r]=NEG; if(kv+32>qrel)p1[r]=NEG;}
}

constexpr int NSLOT=3, SLOTB=8192;
constexpr int LDS_K=0, LDS_V=NSLOT*SLOTB, LDS_WS=2*NSLOT*SLOTB, LDS_OST=LDS_WS+NW*64*4, LDS_RB=LDS_OST+NW*4096, LDS_CB=LDS_RB+1024, LDS_BYTES=LDS_CB+SEQ*4;
constexpr float C2=0.125f*1.4426950408889634f;
__device__ __forceinline__ void glds16(const void*gsrc,unsigned lds_dst){unsigned keep;
  asm volatile("s_mov_b32 %0, m0\n\ts_mov_b32 m0, %2\n\ts_nop 0\n\tglobal_load_lds_dwordx4 %1, off\n\ts_mov_b32 m0, %0":"=&s"(keep):"v"(gsrc),"s"(lds_dst):"memory");}
__device__ __forceinline__ float max3f(float a,float b,float c){float r;asm("v_max3_f32 %0, %1, %2, %3":"=v"(r):"v"(a),"v"(b),"v"(c));return r;}
__device__ __forceinline__ float max2f(float a,float b){float r;asm("v_max_f32_e32 %0, %1, %2":"=v"(r):"v"(a),"v"(b));return r;}
__device__ __forceinline__ float fadd_s(float a,float b){float r;asm("v_add_f32_e32 %0, %1, %2":"=v"(r):"v"(a),"v"(b));return r;}
__device__ __forceinline__ float fsub_s(float a,float b){float r;asm("v_sub_f32_e32 %0, %1, %2":"=v"(r):"v"(a),"v"(b));return r;}
typedef float f32x2_t __attribute__((ext_vector_type(2))); typedef __bf16 bf16x2_t __attribute__((ext_vector_type(2)));
__device__ __forceinline__ unsigned cvtpk_s(float lo,float hi){f32x2_t v={lo,hi};bf16x2_t b=__builtin_convertvector(v,bf16x2_t);return __builtin_bit_cast(unsigned,b);}
#define WAIT_BAR(N) asm volatile("s_waitcnt vmcnt(" #N ") lgkmcnt(0)\n\ts_barrier":::"memory")

__device__ __forceinline__ void qkt(f32x16&p0,f32x16&p1,const char*Kslot,const bf16x8*qr,const f32x16&negm,int r32,int hi){
  const char*kb=Kslot+hi*1024+r32*16;
  #pragma unroll
  for(int d0=0;d0<4;++d0){
    const bf16x8 b0=*reinterpret_cast<const bf16x8*>(kb+d0*2048);
    const bf16x8 b1=*reinterpret_cast<const bf16x8*>(kb+d0*2048+512);
    if(d0==0){p0=__builtin_amdgcn_mfma_f32_32x32x16_bf16(b0,qr[0],negm,0,0,0);p1=__builtin_amdgcn_mfma_f32_32x32x16_bf16(b1,qr[0],negm,0,0,0);}
    else{p0=__builtin_amdgcn_mfma_f32_32x32x16_bf16(b0,qr[d0],p0,0,0,0);p1=__builtin_amdgcn_mfma_f32_32x32x16_bf16(b1,qr[d0],p1,0,0,0);}}
}
typedef __attribute__((address_space(3))) const char* lds_cptr;
typedef short v4i16_t __attribute__((ext_vector_type(4)));
__device__ __forceinline__ void kload8(bf16x8*kf,lds_cptr kp){
  kf[0]=*(const __attribute__((address_space(3))) bf16x8*)(kp);      kf[1]=*(const __attribute__((address_space(3))) bf16x8*)(kp+512);
  kf[2]=*(const __attribute__((address_space(3))) bf16x8*)(kp+2048); kf[3]=*(const __attribute__((address_space(3))) bf16x8*)(kp+2560);
  kf[4]=*(const __attribute__((address_space(3))) bf16x8*)(kp+4096); kf[5]=*(const __attribute__((address_space(3))) bf16x8*)(kp+4608);
  kf[6]=*(const __attribute__((address_space(3))) bf16x8*)(kp+6144); kf[7]=*(const __attribute__((address_space(3))) bf16x8*)(kp+6656);
}
__device__ __forceinline__ void kload2(bf16x8*kf,lds_cptr kp,int j){ kf[2*j]=*(const __attribute__((address_space(3))) bf16x8*)(kp+j*2048); kf[2*j+1]=*(const __attribute__((address_space(3))) bf16x8*)(kp+j*2048+512); }
__device__ __forceinline__ s16x4 vtr(lds_cptr p){ return __builtin_bit_cast(s16x4,__builtin_amdgcn_ds_read_tr16_b64_v4i16((__attribute__((address_space(3))) v4i16_t*)p)); }
__device__ __forceinline__ float rowmax(const f32x16&p0,const f32x16&p1){
  float a=max3f(p0[0],p0[1],p1[0]),b=max3f(p0[2],p0[3],p1[1]);a=max3f(a,p1[2],p1[3]);
  #pragma unroll
  for(int r=4;r<16;r+=4){a=max3f(a,p0[r],p0[r+1]);b=max3f(b,p0[r+2],p0[r+3]);a=max3f(a,p1[r],p1[r+1]);b=max3f(b,p1[r+2],p1[r+3]);}
  const float m=max2f(a,b);
  auto rr=__builtin_amdgcn_permlane32_swap(__float_as_uint(m),__float_as_uint(m),false,false);
  return max2f(__uint_as_float(rr[0]),__uint_as_float(rr[1]));
}
__device__ __forceinline__ void pv(f32x16*o,int vb,bf16x8 pa0,bf16x8 pa1,bf16x8 pa2,bf16x8 pa3){
  #pragma unroll
  for(int d0=0;d0<2;++d0){s16x4 lo[4],hi[4];
    #pragma unroll
    for(int ks=0;ks<4;++ks){
      asm volatile("ds_read_b64_tr_b16 %0,%1 offset:%c2":"=&v"(lo[ks]):"v"(vb),"i"(d0*4096+ks*1024):"memory");
      asm volatile("ds_read_b64_tr_b16 %0,%1 offset:%c2":"=&v"(hi[ks]):"v"(vb),"i"(d0*4096+ks*1024+512):"memory");}
    asm volatile("s_waitcnt lgkmcnt(0)":::"memory");SBAR();
    #define PK(k) (bf16x8){lo[k][0],lo[k][1],lo[k][2],lo[k][3],hi[k][0],hi[k][1],hi[k][2],hi[k][3]}
    o[d0]=__builtin_amdgcn_mfma_f32_32x32x16_bf16(pa0,PK(0),o[d0],0,0,0);
    o[d0]=__builtin_amdgcn_mfma_f32_32x32x16_bf16(pa1,PK(1),o[d0],0,0,0);
    o[d0]=__builtin_amdgcn_mfma_f32_32x32x16_bf16(pa2,PK(2),o[d0],0,0,0);
    o[d0]=__builtin_amdgcn_mfma_f32_32x32x16_bf16(pa3,PK(3),o[d0],0,0,0);
    #undef PK
  }
}

#ifndef ATTN_STORE16
#define ATTN_STORE16(p,v) (*(u32x4*)(p)=(v))
#endif
template<int KIND> __device__ __forceinline__ f32x16 mk_negt(const f32x16&negm,float mhat,unsigned selw,int t){ if constexpr(KIND!=1){return negm;} else { const float v=((selw>>(t>>2))&1u)?-mhat:-1e30f; f32x16 x; _Pragma("unroll") for(int r=0;r<16;++r)x[r]=v; return x; } }
template<int THRL,int KIND> __device__ __forceinline__ void attn_unit(const bf16*Qlane,const bf16*__restrict__ Kh,const bf16*__restrict__ Vh,const int NT,const int NTs,char*shm,const float*cbh,const unsigned selw_in,const float*relb,const int h,bf16*Odirect,const int pidx,bf16*PO,float*PL,const int trel){
  int tid=threadIdx.x; asm volatile("":"+v"(tid)); const int lane=tid&63,r32=lane&31,hi=lane>>5; const int wid=__builtin_amdgcn_readfirstlane(tid>>6);
  const unsigned lds0=(unsigned)(uintptr_t)shm;
  float*wsf=(float*)(shm+LDS_WS)+wid*64;
  const bf16*ksrc=Kh+(long)lane*DM+wid*8;
  const bf16*vsrc=Vh+(long)(16*(wid&3)+(lane>>2))*DM+(wid>>2)*32+(lane&3)*8;
  const unsigned kdst=lds0+LDS_K+wid*1024, vdst=lds0+LDS_V+wid*1024;
  #define TI(t) ((KIND==0)?(NT-1-(t)):(t))
  #define DMA_K(t,slot) glds16(ksrc+(long)TI(t)*KVBLK*DM,(unsigned)__builtin_amdgcn_readfirstlane(kdst+(slot)))
  #define DMA_V(t,slot) glds16(vsrc+(long)TI(t)*KVBLK*DM,(unsigned)__builtin_amdgcn_readfirstlane(vdst+(slot)))
  const int vb0=(int)(lds0+LDS_V)+((lane>>4)&1)*32+(lane&3)*8+(4*hi+((lane&15)>>2))*64;
  const char*Kbase=shm+LDS_K; bf16x8 kf[8];
  const lds_cptr shm3=(lds_cptr)shm; const lds_cptr kp0=shm3+LDS_K+hi*1024+r32*16; const lds_cptr vp0=shm3+LDS_V+((lane>>4)&1)*32+(lane&3)*8+(4*hi+((lane&15)>>2))*64;
  DMA_K(0,0);DMA_V(0,0);DMA_K(1,SLOTB);
  bf16x8 qr[4];
  #pragma unroll
  for(int d0=0;d0<4;++d0)qr[d0]=*reinterpret_cast<const bf16x8*>(&Qlane[d0*16+hi*8]);
  float mhat=0.f,l_reg=0.f;f32x16 o[2];o[0]=f32x16{};o[1]=f32x16{};float z0_=0.f; asm volatile("":"+v"(z0_)); f32x16 negm; _Pragma("unroll") for(int r=0;r<16;++r)negm[r]=z0_; asm volatile("":"+v"(negm));
  const int qrel=wid*QBLK+r32;
  #define HKA(P0,P1,t) do{ if constexpr(KIND==0){ const lds_f32* cp_=cbl+64*TI(t)+4*hi; \
      _Pragma("unroll") for(int g_=0;g_<4;++g_){ const f32x4v a_=*(const lds_f32x4*)(cp_+8*g_); const f32x4v b_=*(const lds_f32x4*)(cp_+32+8*g_); \
        _Pragma("unroll") for(int j_=0;j_<4;++j_){ P0[4*g_+j_]+=a_[j_]; P1[4*g_+j_]+=b_[j_]; } } } }while(0)
  #define CMASK(P0,P1,t) do{int jb_=TI(t)-(NT-4); if constexpr(KIND==0){ if(jb_>=0)cmask(P0,P1,jb_,qrel,hi); } else if constexpr(KIND==1){ if(jb_>=-2){ const float NEG_=-INFINITY; const int kb_=64*jb_+4*hi; \
      _Pragma("unroll") for(int r=0;r<16;++r){ const int d0_=qrel-(kb_+(r&3)+8*(r>>2)); const int d1_=d0_-32; \
        const float b0_=rbl[d0_<0?0:(d0_>128?128:d0_)], b1_=rbl[d1_<0?0:(d1_>128?128:d1_)]; \
        P0[r]=d0_<0?NEG_:P0[r]+b0_; P1[r]=d1_<0?NEG_:P1[r]+b1_; } } } \
    else { if(__any(trel<64*(t)+191)){ const int kb_=64*(t)+4*hi; \
      _Pragma("unroll") for(int r=0;r<16;++r){ const int d0_=trel-(kb_+(r&3)+8*(r>>2)); const int d1_=d0_-32; \
        P0[r]+=rbl[d0_>128?128:d0_]; P1[r]+=rbl[d1_>128?128:d1_]; } } } }while(0)
  bool resc=false;
  #define START(P0,P1) do{ const float rm=rowmax(P0,P1); resc=false; \
    { const float dl=__builtin_fmaxf(rm,-64.f); mhat=fadd_s(mhat,dl); \
      _Pragma("unroll") for(int r=0;r<16;++r){P0[r]=fsub_s(P0[r],dl);P1[r]=fsub_s(P1[r],dl);} \
      _Pragma("unroll") for(int r=0;r<16;++r)negm[r]=-mhat; asm volatile("":"+v"(negm)); } \
    _Pragma("unroll") for(int r=0;r<16;++r)P0[r]=__builtin_amdgcn_exp2f(P0[r]); }while(0)
  #define RESC() do{ if(resc){ asm volatile("s_waitcnt lgkmcnt(0)":::"memory"); \
      _Pragma("unroll") for(int d_=0;d_<2;++d_) _Pragma("unroll") for(int r=0;r<16;++r)o[d_][r]*=wsf[crow(r,hi)]; } }while(0)
  f32x16 pA0,pA1,pB0,pB1;
  int sl_prev=0,sl_cur=0,sl_next=SLOTB;
  #define ROT() do{sl_prev=sl_cur;sl_cur=sl_next;sl_next=(sl_next==(NSLOT-1)*SLOTB)?0:sl_next+SLOTB;}while(0)
  DMA_K(2,2*SLOTB);
  typedef __attribute__((address_space(3))) float lds_f32; typedef __attribute__((address_space(3))) f32x4v lds_f32x4;
  lds_f32* const cbl=(lds_f32*)(shm3+LDS_CB); lds_f32* const rbl=(lds_f32*)(shm3+LDS_RB);
  unsigned selw=0u;
  if constexpr(KIND==0){ const int n4=NT*16; for(int i=(NT-NTs)*16+tid;i<n4;i+=512) ((lds_f32x4*)cbl)[i]=((const f32x4v*)cbh)[i]; }
  else { selw=selw_in;
    if(tid<=128){ float v=0.f; if(tid<128){ int bk=tid; if(tid>=16){ bk=16+(int)(__builtin_log2f((float)tid*0.0625f)*(16.f/3.f)); bk=bk>31?31:bk; } v=(relb[bk*8+h]-relb[31*8+h])*1.4426950408889634f; } rbl[tid]=v; } }
  WAIT_BAR(3);
  { const f32x16 negt0=mk_negt<KIND>(negm,mhat,selw,0); qkt(pA0,pA1,Kbase,qr,negt0,r32,hi); }asm volatile("s_nop 15\n\ts_nop 7":"+v"(pA0),"+v"(pA1));HKA(pA0,pA1,0);CMASK(pA0,pA1,0);
  START(pA0,pA1);
  _Pragma("unroll") for(int r=0;r<16;++r)pA1[r]=__builtin_amdgcn_exp2f(pA1[r]);
  WAIT_BAR(0);
  DMA_K(3,0);DMA_V(1,SLOTB);
  ROT();
  kload8(kf,kp0+sl_cur);
  WAIT_BAR(2);
  s16x4 vlo[8],vhi[8]; u32x4 pw0,pw1,pw2,pw3;
  #define PKW(P,B) cvtpk_s(P[B],P[B+1])
  #define PAF(k) __builtin_bit_cast(bf16x8,pw##k)
  #define VFR(i) (bf16x8){vlo[i][0],vlo[i][1],vlo[i][2],vlo[i][3],vhi[i][0],vhi[i][1],vhi[i][2],vhi[i][3]}
  #define PIN(x) asm volatile("":"+v"(x))
  #define MX3(a,b,c) __builtin_fmaxf(__builtin_fmaxf((a),(b)),(c))
  #define GAPA(MF,A0,A1,A2,A3,W0,W1,PW) do{ MF; sacc+=A0; sacc+=A1; sacc+=A2; sacc+=A3; PIN(sacc); W0; W1; PIN(PW); SBAR(); }while(0)
  #define EX(v) __builtin_amdgcn_exp2f(v)
  #define GAPB(MF,X,B) do{ MF; X[B]=EX(X[B]); X[B+1]=EX(X[B+1]); X[B+2]=EX(X[B+2]); X[B+3]=EX(X[B+3]); PIN(X); SBAR(); }while(0)
  #define VRD(i) do{ vlo[i]=vtr(vp_+(((i)>>2)*4096+((i)&3)*1024)); vhi[i]=vtr(vp_+(((i)>>2)*4096+((i)&3)*1024+512)); }while(0)
  #define KRD(G,j) do{ if(G){ kload2(kf,kp0+sl_next,j); SBAR(); } }while(0)
  #define STEP(C0,C1,P0,P1,t,GK,GV,GL) do{ SBAR(); \
    const lds_cptr vp_=vp0+sl_prev; const f32x16 negt_=mk_negt<KIND>(negm,mhat,selw,(t)); \
    VRD(0); SBAR(); float sacc=(P0[0]+P0[1]); \
    GAPA(C0=__builtin_amdgcn_mfma_f32_32x32x16_bf16(kf[0],qr[0],negt_,0,0,0), P0[2],P0[3],P0[4],P0[5],     pw0[0]=PKW(P0,0), pw0[1]=PKW(P0,2), pw0); \
    VRD(4); SBAR(); GAPA(C1=__builtin_amdgcn_mfma_f32_32x32x16_bf16(kf[1],qr[0],negt_,0,0,0), P0[6],P0[7],P0[8],P0[9],     pw0[2]=PKW(P0,4), pw0[3]=PKW(P0,6), pw0); \
    VRD(1); SBAR(); GAPA(C0=__builtin_amdgcn_mfma_f32_32x32x16_bf16(kf[2],qr[1],C0,0,0,0),   P0[10],P0[11],P0[12],P0[13], pw1[0]=PKW(P0,8), pw1[1]=PKW(P0,10), pw1); \
    VRD(5); SBAR(); GAPA(C1=__builtin_amdgcn_mfma_f32_32x32x16_bf16(kf[3],qr[1],C1,0,0,0),   P0[14],P0[15],P1[0],P1[1],   pw1[2]=PKW(P0,12),pw1[3]=PKW(P0,14), pw1); \
    VRD(2); SBAR(); GAPA(C0=__builtin_amdgcn_mfma_f32_32x32x16_bf16(kf[4],qr[2],C0,0,0,0),   P1[2],P1[3],P1[4],P1[5],     pw2[0]=PKW(P1,0), pw2[1]=PKW(P1,2), pw2); \
    VRD(6); SBAR(); GAPA(C1=__builtin_amdgcn_mfma_f32_32x32x16_bf16(kf[5],qr[2],C1,0,0,0),   P1[6],P1[7],P1[8],P1[9],     pw2[2]=PKW(P1,4), pw2[3]=PKW(P1,6), pw2); \
    VRD(3); SBAR(); GAPA(C0=__builtin_amdgcn_mfma_f32_32x32x16_bf16(kf[6],qr[3],C0,0,0,0),   P1[10],P1[11],P1[12],P1[13], pw3[0]=PKW(P1,8), pw3[1]=PKW(P1,10), pw3); \
    VRD(7); SBAR(); GAPA(C1=__builtin_amdgcn_mfma_f32_32x32x16_bf16(kf[7],qr[3],C1,0,0,0),   P1[14],P1[15],0.f,0.f,       pw3[2]=PKW(P1,12),pw3[3]=PKW(P1,14), pw3); \
    l_reg+=sacc; \
    if(GK){DMA_K((t)+3,sl_cur);} if(GV){DMA_V((t)+1,sl_next);} \
    HKA(C0,C1,t); CMASK(C0,C1,t); \
    { float a=MX3(C0[0],C0[1],C1[0]),b=MX3(C0[2],C0[3],C1[1]); a=MX3(a,C1[2],C1[3]); \
      _Pragma("unroll") for(int r=4;r<16;r+=4){a=MX3(a,C0[r],C0[r+1]);b=MX3(b,C0[r+2],C0[r+3]);a=MX3(a,C1[r],C1[r+1]);b=MX3(b,C1[r+2],C1[r+3]);} \
      float rm=__builtin_fmaxf(a,b); { auto rr=__builtin_amdgcn_permlane32_swap(__float_as_uint(rm),__float_as_uint(rm),false,false); rm=__builtin_fmaxf(__uint_as_float(rr[0]),__uint_as_float(rr[1])); } \
      resc=false; \
      if(__builtin_expect(__any(rm>(float)THRL),0)){ const float dl=__builtin_fmaxf(rm,0.f); mhat+=dl; \
        _Pragma("unroll") for(int r=0;r<16;++r){C0[r]-=dl;C1[r]-=dl;} \
        _Pragma("unroll") for(int r=0;r<16;++r)negm[r]=-mhat; asm volatile("":"+v"(negm)); \
        const float f=__builtin_amdgcn_exp2f(-dl); l_reg*=f; if(hi==0)wsf[r32]=f; resc=true; } } \
    SBAR(); \
    GAPB(o[0]=__builtin_amdgcn_mfma_f32_32x32x16_bf16(PAF(0),VFR(0),o[0],0,0,0), C0,0); \
    GAPB(o[1]=__builtin_amdgcn_mfma_f32_32x32x16_bf16(PAF(0),VFR(4),o[1],0,0,0), C0,4); \
    KRD(GL,0); GAPB(o[0]=__builtin_amdgcn_mfma_f32_32x32x16_bf16(PAF(1),VFR(1),o[0],0,0,0), C0,8); \
    KRD(GL,1); GAPB(o[1]=__builtin_amdgcn_mfma_f32_32x32x16_bf16(PAF(1),VFR(5),o[1],0,0,0), C0,12); \
    KRD(GL,2); GAPB(o[0]=__builtin_amdgcn_mfma_f32_32x32x16_bf16(PAF(2),VFR(2),o[0],0,0,0), C1,0); \
    KRD(GL,3); GAPB(o[1]=__builtin_amdgcn_mfma_f32_32x32x16_bf16(PAF(2),VFR(6),o[1],0,0,0), C1,4); \
    GAPB(o[0]=__builtin_amdgcn_mfma_f32_32x32x16_bf16(PAF(3),VFR(3),o[0],0,0,0), C1,8); \
    GAPB(o[1]=__builtin_amdgcn_mfma_f32_32x32x16_bf16(PAF(3),VFR(7),o[1],0,0,0), C1,12); \
    }while(0)
  int t=1;
  for(;t+(KIND==1?7:5)<NTs;t+=2){
    STEP(pB0,pB1,pA0,pA1,t,true,true,true);     WAIT_BAR(2); RESC(); ROT();
    STEP(pA0,pA1,pB0,pB1,t+1,true,true,true);   WAIT_BAR(2); RESC(); ROT();
  }
  #define ENDW(tt) do{ if((tt)+3<NTs){WAIT_BAR(2);} else if((tt)+2<NTs){WAIT_BAR(1);} else {WAIT_BAR(0);} }while(0)
  for(;t+1<NTs;t+=2){
    STEP(pB0,pB1,pA0,pA1,t,(t+3<NTs),(t+1<NTs),(t+1<NTs));       ENDW(t);   RESC(); ROT();
    STEP(pA0,pA1,pB0,pB1,t+1,(t+4<NTs),(t+2<NTs),(t+2<NTs));     ENDW(t+1); RESC(); ROT();
  }
  STEP(pB0,pB1,pA0,pA1,NTs-1,false,false,false); RESC();
  { float sacc=pB0[0]+pB0[1]; _Pragma("unroll") for(int r=2;r<16;++r)sacc+=pB0[r]; _Pragma("unroll") for(int r=0;r<16;++r)sacc+=pB1[r]; l_reg+=sacc;
    pw0=(u32x4){PKW(pB0,0),PKW(pB0,2),PKW(pB0,4),PKW(pB0,6)};pw1=(u32x4){PKW(pB0,8),PKW(pB0,10),PKW(pB0,12),PKW(pB0,14)};pw2=(u32x4){PKW(pB1,0),PKW(pB1,2),PKW(pB1,4),PKW(pB1,6)};pw3=(u32x4){PKW(pB1,8),PKW(pB1,10),PKW(pB1,12),PKW(pB1,14)};
    SBAR(); pv(o,vb0+sl_cur,PAF(0),PAF(1),PAF(2),PAF(3)); }
  #undef PKW
  #undef PAF
  #undef VFR
  #undef PIN
  #undef MX3
  #undef GAPA
  #undef GAPB
  #undef EX
  #undef VRD
  #undef KRD
  #undef STEP
  #undef ENDW
  {auto rr=__builtin_amdgcn_permlane32_swap(__float_as_uint(l_reg),__float_as_uint(l_reg),false,false);l_reg=__uint_as_float(rr[0])+__uint_as_float(rr[1]);}
  if(hi==0)wsf[32+r32]=l_reg;asm volatile("s_waitcnt lgkmcnt(0)":::"memory");
  float rli[16];
  #pragma unroll
  for(int r=0;r<16;++r)rli[r]=__builtin_amdgcn_rcpf(wsf[32+crow(r,hi)]);
  typedef __attribute__((address_space(3))) int lds_i32; lds_i32* const dstt=(lds_i32*)(shm3+LDS_CB)+wid*32;
  if constexpr(KIND!=0){ if(hi==0){ dstt[r32]=pidx; if(pidx>=0) PL[pidx]=mhat+__builtin_log2f(l_reg); } }
  { bf16*stg=(bf16*)(shm+LDS_OST)+wid*2048;
    #pragma unroll
    for(int r=0;r<16;++r){const int orow=crow(r,hi);
      #pragma unroll
      for(int d0=0;d0<2;++d0)stg[orow*64+d0*32+r32]=__float2bfloat16(o[d0][r]*rli[r]);}
    asm volatile("s_waitcnt lgkmcnt(0)":::"memory");
    #pragma unroll
    for(int i=0;i<4;++i){const int row=i*8+(lane>>3),ch=lane&7; const u32x4 v=*(const u32x4*)(stg+row*64+ch*8);
      if constexpr(KIND==0){ ATTN_STORE16(Odirect+(long)row*DM+ch*8,v); } else { const int d_=dstt[row]; if(d_>=0) ATTN_STORE16(PO+(long)d_*64+ch*8,v); } } }
  asm volatile("s_waitcnt lgkmcnt(0)\n\ts_barrier":::"memory");
  #undef DMA_K
  #undef TI
  #undef DMA_V
  #undef CMASK
  #undef HKA
  #undef START
  #undef RESC
  #undef ROT
}
constexpr int ATTN_LDS_BYTES=LDS_BYTES;
#undef SBAR
#undef WAIT_BAR
}
#include <hip/hip_cooperative_groups.h>
namespace cg = cooperative_groups;
constexpr int NWAVES = 8, M_ROWS = 32768;
constexpr int Bn = 4, S = 8192, D = 1024, FF = 2816, M = Bn * S, PLE = 256, DEPTH = 2;
constexpr float LN_EPS = 1e-5f, DN_ALPHA = 1.4142135623730951f  ;
constexpr size_t MiB = 1u << 20;
constexpr size_t WS_WGU = 2 * MiB, WS_WD = 46 * MiB, WS_WIN = 68 * MiB, WS_WOUT = 74 * MiB, WS_WSIN = 76 * MiB, WS_WSOUT = 80 * MiB, WS_WPG = 82 * MiB, WS_WPP = 86 * MiB;
constexpr size_t WS_WSB = 87 * MiB, WS_WF = 87 * MiB + 256 * 1024, WS_KBAR = 87 * MiB + 512 * 1024, WS_LOGF = 88 * MiB, WS_CB = 89 * MiB, WS_SELM = 90 * MiB;
constexpr size_t WS_PB = 92 * MiB, WS_XB = 124 * MiB, WS_R = 188 * MiB, WS_XB1 = 380 * MiB, WS_PCS = 444 * MiB, WS_PCB = 446 * MiB, WS_SP = 448 * MiB, WS_LST = 454 * MiB, WS_PL = 486 * MiB, WS_WCNT = 490 * MiB, WS_LEN = 491 * MiB, WS_END = 492 * MiB;
constexpr size_t WS_CS = 64 * 1024, WS_LCB = 192 * 1024, WS_CBF = 320 * 1024;
constexpr int PSTR = 18432, CS_WIN = 0, CS_WSIN = 3072, CS_WGU01 = 5120, CS_WGU11 = 10752, CS_WPG0 = 16384, CS_WPG1 = 17408;
constexpr size_t SP_SZ = (size_t)M_ROWS * 4 * 2 * 4;
constexpr size_t SZ_WGU = (size_t)2 * FF * D * 2, SZ_WD = (size_t)D * FF * 2;
constexpr int LDS_BYTES = 147456;
constexpr int HP = 3072;
#define GAS __attribute__((address_space(1)))
#define LAS __attribute__((address_space(3)))
typedef unsigned short bf16;
typedef unsigned v4u __attribute__((ext_vector_type(4)));
typedef unsigned v2u __attribute__((ext_vector_type(2)));
typedef float f32x4 __attribute__((ext_vector_type(4)));
typedef short bf16x8 __attribute__((ext_vector_type(8)));
#define LDS_WAIT() asm volatile("s_waitcnt lgkmcnt(0)" ::: "memory")
__device__ __forceinline__ unsigned f2bf(float f) { unsigned u = __builtin_bit_cast(unsigned, f); return (u + 0x7fffu + ((u >> 16) & 1u)) >> 16; }
__device__ __forceinline__ unsigned pk2(float lo, float hi) { return f2bf(lo) | (f2bf(hi) << 16); }
__device__ __forceinline__ float bflo(unsigned w) { return __uint_as_float(w << 16); }
__device__ __forceinline__ float bfhi(unsigned w) { return __uint_as_float(w & 0xffff0000u); }
__device__ __forceinline__ float wave_sum(float v) {
#pragma unroll
    for (int o = 1; o < 64; o <<= 1) v += __shfl_xor(v, o);
    return v;
}
struct Args { const float* in[20]; float* out; unsigned char* ws; int ph_lo, ph_hi; };

__device__ __forceinline__ void transpose_item(const float* W, int K, int nblk, int ldn, bf16* WT, int mode, LAS float* scr, int item, int lane, const float* lg = nullptr, const float* lb = nullptr, float* pcs = nullptr, float* pcb = nullptr) {
    const int kb = item / nblk, nb = item % nblk, k0 = 64 * kb, n0 = 32 * nb;
    int r0 = n0;
    if (mode == 1) r0 = (n0 >> 7) * 256 + (n0 & 127);
    else if (mode == 2) r0 = (n0 >> 7) * 256 + 128 + (n0 & 127);
    else if (mode == 3) { if (n0 < 1536) r0 = (n0 / 512) * 1024 + (n0 % 512); else { const int n1 = n0 - 1536; r0 = (n1 / 512) * 1024 + 512 + (n1 % 512); } }
#pragma unroll 8
    for (int i = 0; i < 32; ++i) { const int kk = 2 * i + (lane >> 5); scr[kk * 33 + (lane & 31)] = W[(size_t)(k0 + kk) * ldn + n0 + (lane & 31)]; }
    LDS_WAIT(); asm volatile("" ::: "memory");
    const int c = lane & 7;
    f32x4 gq0 = {1.f, 1.f, 1.f, 1.f}, gq1 = {1.f, 1.f, 1.f, 1.f};
    if (lg) { gq0 = *(const f32x4*)(lg + k0 + 8 * c); gq1 = *(const f32x4*)(lg + k0 + 8 * c + 4); }
#pragma unroll
    for (int j = 0; j < 4; ++j) { const int n = (lane >> 3) + 8 * j; const LAS float* s = scr + (8 * c) * 33 + n;
        v4u o; o.x = pk2(s[0 * 33] * gq0[0], s[1 * 33] * gq0[1]); o.y = pk2(s[2 * 33] * gq0[2], s[3 * 33] * gq0[3]); o.z = pk2(s[4 * 33] * gq1[0], s[5 * 33] * gq1[1]); o.w = pk2(s[6 * 33] * gq1[2], s[7 * 33] * gq1[3]);
        if (mode == 4) *(v4u*)(WT + ((size_t)kb * (nblk * 32) + (r0 + n)) * 64 + 8 * c) = o;
        else *(v4u*)(WT + (size_t)(r0 + n) * K + k0 + 8 * c) = o; }
    if (lg) { const int n = lane & 31; float acc = 0.f;
#pragma unroll 8
        for (int kk = 0; kk < 64; ++kk) { const float w = scr[kk * 33 + n]; const float gk = lg[k0 + kk], bk = lb[k0 + kk]; acc += (lane < 32) ? __uint_as_float(f2bf(w * gk) << 16) : w * bk; }
        ((lane < 32) ? pcs : pcb)[(size_t)kb * PSTR + r0 + n] = acc; }
    LDS_WAIT(); asm volatile("" ::: "memory");
}
__device__ __forceinline__ void cvt_copy(const float* src, bf16* dst, size_t n8, size_t gt, size_t ngt) {
    for (size_t i = gt; i < n8; i += ngt) { const f32x4 a = ((const f32x4*)src)[2 * i], b = ((const f32x4*)src)[2 * i + 1];
        v4u o; o.x = pk2(a[0], a[1]); o.y = pk2(a[2], a[3]); o.z = pk2(b[0], b[1]); o.w = pk2(b[2], b[3]); ((v4u*)dst)[i] = o; }
}
__device__ __forceinline__ void p0_prologue(const Args& a, LAS unsigned char* lds, int tid, int lane, int wave) {
    const int BID = lbid(), GRD = lgrid();
    unsigned char* ws = a.ws;
    LAS float* scr = (LAS float*)(lds + wave * 16384);
    const int G = GRD, gw = BID * NWAVES + wave, NGW = G * NWAVES;
    constexpr int I_GU = (D / 64) * (FF / 32), I_D = (FF / 64) * (D / 32), I_IN = (D / 64) * (3072 / 32), I_SQ = (D / 64) * (D / 32), I_SIN = (D / 64) * (2048 / 32), I_PP = (PLE / 64) * (D / 32);
    constexpr int NITEMS = 8 * I_GU + 4 * I_D + I_IN + I_SQ + I_SIN + I_SQ + 2 * I_SQ + 2 * I_PP;
    for (int it = gw; it < NITEMS; it += NGW) {
        int r = it;
        if (r < 8 * I_GU) { const int j = r / I_GU, mat = j >> 1, up = j & 1; r -= j * I_GU;
            const bool ln = (mat & 1); const int li_ = mat >> 1;
            transpose_item((up ? a.in[5] : a.in[4]) + (size_t)mat * D * FF, D, FF / 32, FF, (bf16*)(ws + WS_WGU + (size_t)mat * SZ_WGU), up ? 2 : 1, scr, r, lane,
                           ln ? a.in[2] + (li_ * 3 + 1) * D : nullptr, ln ? a.in[3] + (li_ * 3 + 1) * D : nullptr, (float*)(ws + WS_PCS) + (li_ ? CS_WGU11 : CS_WGU01), (float*)(ws + WS_PCB) + (li_ ? CS_WGU11 : CS_WGU01)); continue; } r -= 8 * I_GU;
        if (r < 4 * I_D) { const int mat = r / I_D; r -= mat * I_D; transpose_item(a.in[6] + (size_t)mat * FF * D, FF, D / 32, D, (bf16*)(ws + WS_WD + (size_t)mat * SZ_WD), 4, scr, r, lane); continue; } r -= 4 * I_D;
        if (r < I_IN) { transpose_item(a.in[7], D, 3072 / 32, 3080, (bf16*)(ws + WS_WIN), 3, scr, r, lane, a.in[2], a.in[3], (float*)(ws + WS_PCS) + CS_WIN, (float*)(ws + WS_PCB) + CS_WIN); continue; } r -= I_IN;
        if (r < I_SQ) { transpose_item(a.in[9], D, D / 32, D, (bf16*)(ws + WS_WOUT), 0, scr, r, lane); continue; } r -= I_SQ;
        if (r < I_SIN) { transpose_item(a.in[11], D, 2048 / 32, 2048, (bf16*)(ws + WS_WSIN), 0, scr, r, lane, a.in[2] + 3 * D, a.in[3] + 3 * D, (float*)(ws + WS_PCS) + CS_WSIN, (float*)(ws + WS_PCB) + CS_WSIN); continue; } r -= I_SIN;
        if (r < I_SQ) { transpose_item(a.in[17], D, D / 32, D, (bf16*)(ws + WS_WSOUT), 0, scr, r, lane); continue; } r -= I_SQ;
        if (r < 2 * I_SQ) { const int mat = r / I_SQ; r -= mat * I_SQ; transpose_item(a.in[19] + (size_t)mat * D * D, D, D / 32, D, (bf16*)(ws + WS_WPG + (size_t)mat * D * D * 2), 0, scr, r, lane, a.in[2] + (mat * 3 + 2) * D, a.in[3] + (mat * 3 + 2) * D, (float*)(ws + WS_PCS) + (mat ? CS_WPG1 : CS_WPG0), (float*)(ws + WS_PCB) + (mat ? CS_WPG1 : CS_WPG0)); continue; } r -= 2 * I_SQ;
        { const int mat = r / I_PP; r -= mat * I_PP; transpose_item(a.in[18] + (size_t)mat * PLE * D, PLE, D / 32, D, (bf16*)(ws + WS_WPP + (size_t)mat * D * PLE * 2), 0, scr, r, lane); }
    }
    const size_t gt = (size_t)BID * 512 + tid, ngt = (size_t)G * 512;
    cvt_copy(a.in[0], (bf16*)(ws + WS_XB), (size_t)M * D / 8, gt, ngt);
    cvt_copy(a.in[1], (bf16*)(ws + WS_PB), (size_t)DEPTH * M * PLE / 8, gt, ngt);
    for (size_t i = gt; i < 8 * 128 * 128; i += ngt) { const int t = (int)(i >> 7) & 127, s = (int)i & 127; ((bf16*)(ws + WS_WSB))[i] = (bf16)(s <= t ? f2bf(a.in[15][i]) : 0u); }
    for (size_t i = gt; i < 8 * 1024; i += ngt) { const int h = (int)(i >> 10), k = (int)i & 1023; ((float*)(ws + WS_WF))[i] = a.in[7][(size_t)k * 3080 + 3072 + h] * a.in[2][k]; }
    for (size_t i = gt; i < 4 * 8 * 32 * 64; i += ngt) ((float*)(ws + WS_KBAR))[i] = 0.f;
    if (BID == 0) for (int i = tid; i < 4096; i += 512) ((unsigned*)ws)[i] = 0u;
}
__device__ __forceinline__ void finalize_cs(const Args& a, int tid, int lane, int wave) {
    const int BID = lbid(), GRD = lgrid();
    unsigned char* ws = a.ws;
    const float* pcs = (const float*)(ws + WS_PCS); const float* pcb = (const float*)(ws + WS_PCB); float* cs = (float*)(ws + WS_CS); float* lcb = (float*)(ws + WS_LCB);
    for (int n = BID * 512 + tid; n < PSTR; n += GRD * 512) { float x = 0.f, y = 0.f;
#pragma unroll
        for (int kb = 0; kb < 16; ++kb) { x += pcs[(size_t)kb * PSTR + n]; y += pcb[(size_t)kb * PSTR + n]; }
        cs[n] = x; lcb[n] = y; }
    if (BID == GRD - 1) { float d = 0.f;
#pragma unroll
        for (int j = 0; j < 16; ++j) { const int k = lane + 64 * j; d += a.in[3][k] * a.in[7][(size_t)k * 3080 + 3072 + wave]; }
        d = wave_sum(d); if (lane == 0) ((float*)(ws + WS_CBF))[wave] = d; }
}
__device__ __forceinline__ void logits_job(const Args& a, const bf16* Z, int lane, int wave) {
    const int BID = lbid(), GRD = lgrid();
    unsigned char* ws = a.ws;
    const float* WF = (const float*)(ws + WS_WF); const float* cbf = (const float*)(ws + WS_CBF); const float* bfp = a.in[8]; float* LOGF = (float*)(ws + WS_LOGF);
    const int gw = BID * NWAVES + wave, NGW = GRD * NWAVES;
    for (int m = gw; m < M; m += NGW) {
        const v2u* xr = (const v2u*)(Z + (size_t)m * D) + lane;
        f32x4 v[4]; float s = 0.f;
#pragma unroll
        for (int j = 0; j < 4; ++j) { const v2u w = xr[64 * j]; v[j] = (f32x4){bflo(w.x), bfhi(w.x), bflo(w.y), bfhi(w.y)}; s += (v[j][0] + v[j][1]) + (v[j][2] + v[j][3]); }
        const float mean = wave_sum(s) * (1.f / D); float s2 = 0.f;
#pragma unroll
        for (int j = 0; j < 4; ++j) { v[j] = v[j] - mean; s2 += (v[j][0] * v[j][0] + v[j][1] * v[j][1]) + (v[j][2] * v[j][2] + v[j][3] * v[j][3]); }
        const float rstd = 1.f / sqrtf(wave_sum(s2) * (1.f / D) + LN_EPS);
        float mine = 0.f;
#pragma unroll
        for (int h = 0; h < 8; ++h) { float d = 0.f;
#pragma unroll
            for (int j = 0; j < 4; ++j) { const f32x4 w = ((const f32x4*)(WF + h * 1024))[64 * j + lane]; d += (v[j][0] * w[0] + v[j][1] * w[1]) + (v[j][2] * w[2] + v[j][3] * w[3]); }
            d = wave_sum(d); if (lane == h) mine = d; }
        if (lane < 8) { const float z = mine * rstd + cbf[lane] + bfp[lane];
            const float e_ = __expf(-fabsf(z)), u_ = 1.f + e_; const float l1p = (u_ == 1.f) ? e_ : __logf(u_) * (e_ / (u_ - 1.f));
            const float ls = fminf(z, 0.f) - l1p;
            const int b = m / S, sidx = m % S; LOGF[((size_t)(b * 8 + lane)) * S + sidx] = ls; }
    }
}
__device__ __forceinline__ void prep_phase(const Args& a, LAS unsigned char* lds, int tid, int lane, int wave) {
    const int BID = lbid(), GRD = lgrid();
    unsigned char* ws = a.ws;
    const float* LOGF = (const float*)(ws + WS_LOGF); float* CB = (float*)(ws + WS_CB);
    if (BID < 32) {
        const float* src = LOGF + (size_t)BID * S + tid * 16; float* dst = CB + (size_t)BID * S + tid * 16;
        float v[16];
#pragma unroll
        for (int j = 0; j < 4; ++j) { const f32x4 x = ((const f32x4*)src)[j]; v[4 * j] = x[0]; v[4 * j + 1] = x[1]; v[4 * j + 2] = x[2]; v[4 * j + 3] = x[3]; }
#pragma unroll
        for (int j = 1; j < 16; ++j) v[j] += v[j - 1];
        float tot = v[15], inc = tot;
#pragma unroll
        for (int o = 1; o < 64; o <<= 1) { const float n = __shfl_up(inc, o); if (lane >= o) inc += n; }
        LAS float* wsum = (LAS float*)lds;
        if (lane == 63) wsum[wave] = inc;
        __syncthreads();
        float base = inc - tot;
        for (int w = 0; w < wave; ++w) base += wsum[w];
#pragma unroll
        for (int j = 0; j < 4; ++j) { f32x4 o; o[0] = -(base + v[4 * j]) * 1.4426950408889634f; o[1] = -(base + v[4 * j + 1]) * 1.4426950408889634f; o[2] = -(base + v[4 * j + 2]) * 1.4426950408889634f; o[3] = -(base + v[4 * j + 3]) * 1.4426950408889634f; ((f32x4*)dst)[j] = o; }
        __syncthreads();
    }
    const bf16* Q = (const bf16*)(ws + WS_R); const float* KBAR = (const float*)(ws + WS_KBAR); unsigned* SELM = (unsigned*)(ws + WS_SELM);
    const int nwv = GRD * NWAVES;
    for (int wv = BID * NWAVES + wave; wv < Bn * 8 * (S / 64); wv += nwv) {
        const int bh = wv / (S / 64), t = (wv % (S / 64)) * 64 + lane; const int b = bh >> 3, h = 8 + (bh & 7);
        const v4u* qp = (const v4u*)(Q + ((size_t)(b * S + t)) * D + h * 64); const v4u* kp = (const v4u*)(Q + (size_t)32 * MiB + ((size_t)(b * S + t)) * D + h * 64);
        float qs = 0.f, ks = 0.f;
#pragma unroll
        for (int c = 0; c < 8; ++c) { const v4u w = qp[c], x = kp[c];
            qs += (bflo(w.x) * bflo(w.x) + bfhi(w.x) * bfhi(w.x)) + (bflo(w.y) * bflo(w.y) + bfhi(w.y) * bfhi(w.y)) + (bflo(w.z) * bflo(w.z) + bfhi(w.z) * bfhi(w.z)) + (bflo(w.w) * bflo(w.w) + bfhi(w.w) * bfhi(w.w));
            ks += (bflo(x.x) * bflo(x.x) + bfhi(x.x) * bfhi(x.x)) + (bflo(x.y) * bflo(x.y) + bfhi(x.y) * bfhi(x.y)) + (bflo(x.z) * bflo(x.z) + bfhi(x.z) * bfhi(x.z)) + (bflo(x.w) * bflo(x.w) + bfhi(x.w) * bfhi(x.w)); }
#pragma unroll
        for (int o = 1; o < 64; o <<= 1) { qs = fmaxf(qs, __shfl_xor(qs, o)); ks = fmaxf(ks, __shfl_xor(ks, o)); }
        if (lane == 0) { atomicMax((unsigned*)ws + 3700 + bh, __float_as_uint(qs)); atomicMax((unsigned*)ws + 3732 + bh, __float_as_uint(ks)); }
    }
    for (int wv = BID * NWAVES + wave; wv < Bn * 8 * (S / 64); wv += nwv) {
        const int bh = __builtin_amdgcn_readfirstlane(wv / (S / 64)), t0 = __builtin_amdgcn_readfirstlane((wv % (S / 64)) * 64);
        const int b = bh >> 3, h = bh & 7, t = t0 + lane, blk = t0 >> 8;
        unsigned mask = 1u << blk;
        if (blk > 0) {
            float q[64];
            const v4u* qp = (const v4u*)(Q + ((size_t)(b * S + t)) * D + h * 64);
#pragma unroll
            for (int c = 0; c < 8; ++c) { const v4u w = qp[c]; q[8 * c] = bflo(w.x); q[8 * c + 1] = bfhi(w.x); q[8 * c + 2] = bflo(w.y); q[8 * c + 3] = bfhi(w.y); q[8 * c + 4] = bflo(w.z); q[8 * c + 5] = bfhi(w.z); q[8 * c + 6] = bflo(w.w); q[8 * c + 7] = bfhi(w.w); }
            float g0 = -3e38f, g1 = -3e38f, g2 = -3e38f; int i0 = -1, i1 = -1, i2 = -1;
            for (int n = 0; n < blk; ++n) {
                const float* kb = KBAR + ((size_t)(bh * 32 + n)) * 64; float gsum = 0.f;
#pragma unroll
                for (int d = 0; d < 64; ++d) gsum += q[d] * kb[d];
                if (gsum > g0) { g2 = g1; i2 = i1; g1 = g0; i1 = i0; g0 = gsum; i0 = n; }
                else if (gsum > g1) { g2 = g1; i2 = i1; g1 = gsum; i1 = n; }
                else if (gsum > g2) { g2 = gsum; i2 = n; }
            }
            if (i0 >= 0) mask |= 1u << i0; if (i1 >= 0) mask |= 1u << i1; if (i2 >= 0) mask |= 1u << i2;
        }
        SELM[(size_t)bh * S + t] = mask;
        unsigned mycnt = 0u;
        for (int n = 0; n < blk; ++n) { const unsigned long long bl = __ballot((mask >> n) & 1u); if (lane == n) mycnt = (unsigned)__popcll(bl); }
        if (lane < 32) ((unsigned*)(ws + WS_WCNT))[((size_t)bh * 128 + (t0 >> 6)) * 32 + lane] = mycnt;
    }
}
__device__ __forceinline__ void lists_phase(const Args& a, int tid, int lane, int wave) {
    const int BID = lbid(), GRD = lgrid();
    unsigned char* ws = a.ws;
    const unsigned* SELM = (const unsigned*)(ws + WS_SELM); const unsigned* WCNT = (const unsigned*)(ws + WS_WCNT); unsigned* LST = (unsigned*)(ws + WS_LST); unsigned* LEN = (unsigned*)(ws + WS_LEN);
    const int nwv = GRD * NWAVES;
    { const int gid = BID * 512 + tid; if (gid < 1024) { const int bh = gid >> 5, qb = gid & 31; const float* cb = (const float*)(ws + WS_CB) + (size_t)bh * S;
        const float B = sqrtf(__uint_as_float(((const unsigned*)ws)[3700 + bh])) * sqrtf(__uint_as_float(((const unsigned*)ws)[3732 + bh])); const float TH = 2.05f * B + 160.f; const float c0 = cb[qb * 256];
        int lo = 0, hi_ = 2 * qb;
        while (lo < hi_) { const int mid = (lo + hi_ + 1) >> 1; if (c0 - cb[128 * mid - 1] >= TH) lo = mid; else hi_ = mid - 1; }
        ((int*)(ws + WS_LEN))[1024 + gid] = 2 * lo; } }
    for (int wv = BID * NWAVES + wave; wv < Bn * 8 * (S / 64); wv += nwv) {
        const int bh = __builtin_amdgcn_readfirstlane(wv / (S / 64)), w = __builtin_amdgcn_readfirstlane(wv % (S / 64));
        const int t = w * 64 + lane, blk = w >> 2;
        unsigned off = 0u;
        if (lane < 32) for (int w2 = 0; w2 < w; ++w2) off += WCNT[((size_t)bh * 128 + w2) * 32 + lane];
        if (w == 127 && lane < 32) LEN[bh * 32 + lane] = off + WCNT[((size_t)bh * 128 + w) * 32 + lane];
        const unsigned mask = SELM[(size_t)bh * S + t] & ~(1u << blk);
        for (int n = 0; n < blk; ++n) {
            const bool sel = (mask >> n) & 1u; const unsigned long long bl = __ballot(sel);
            const unsigned base = (unsigned)__builtin_amdgcn_readlane((int)off, n);
            if (sel) { const unsigned rank = (unsigned)__popcll(bl & ((1ull << lane) - 1ull)); const unsigned slot = 1u + (unsigned)__popc(mask & ((1u << n) - 1u));
                LST[((size_t)bh * 32 + n) * 8192 + base + rank] = (unsigned)t | (slot << 16); }
        }
    }
}
__device__ __forceinline__ void combine_phase(const Args& a, int tid) {
    const int BID = lbid(), GRD = lgrid();
    unsigned char* ws = a.ws;
    const unsigned* SELM = (const unsigned*)(ws + WS_SELM); const float* PL = (const float*)(ws + WS_PL); const bf16* PO = (const bf16*)a.out; bf16* O = (bf16*)(ws + WS_XB1);
    for (size_t it = (size_t)BID * 512 + tid; it < (size_t)Bn * 8 * S * 8; it += (size_t)GRD * 512) {
        const int c = (int)(it & 7); const size_t row = it >> 3; const int t = (int)(row % S), bh = (int)(row / S), blk = t >> 8;
        const int np = __popc(SELM[row] & ~(1u << blk));
        const f32x4 l4 = *(const f32x4*)(PL + row * 4);
        float m = l4[0]; if (np > 0) m = fmaxf(m, l4[1]); if (np > 1) m = fmaxf(m, l4[2]); if (np > 2) m = fmaxf(m, l4[3]);
        float wsum = 0.f; float acc[8] = {0.f, 0.f, 0.f, 0.f, 0.f, 0.f, 0.f, 0.f};
#pragma unroll
        for (int i = 0; i < 4; ++i) if (i <= np) { const float wgt = __builtin_amdgcn_exp2f(l4[i] - m); wsum += wgt; const v4u p = *(const v4u*)(PO + (row * 4 + i) * 64 + c * 8);
            acc[0] += wgt * bflo(p.x); acc[1] += wgt * bfhi(p.x); acc[2] += wgt * bflo(p.y); acc[3] += wgt * bfhi(p.y); acc[4] += wgt * bflo(p.z); acc[5] += wgt * bfhi(p.z); acc[6] += wgt * bflo(p.w); acc[7] += wgt * bfhi(p.w); }
        const float inv = 1.f / wsum; v4u o; o.x = pk2(acc[0] * inv, acc[1] * inv); o.y = pk2(acc[2] * inv, acc[3] * inv); o.z = pk2(acc[4] * inv, acc[5] * inv); o.w = pk2(acc[6] * inv, acc[7] * inv);
        const int b = bh >> 3, h = bh & 7; *(v4u*)(O + ((size_t)(b * S + t)) * D + h * 64 + c * 8) = o;
    }
}
__device__ __forceinline__ void sgu_mix_phase(const Args& a, LAS unsigned char* lds, int tid, int lane, int wave) {
    const int BID = lbid(), GRD = lgrid();
    unsigned char* ws = a.ws;
    const bf16* U = (const bf16*)(ws + WS_R); const bf16* V = (const bf16*)(ws + WS_R + 64 * MiB); bf16* Y = (bf16*)(ws + WS_R + 128 * MiB);
    const bf16* WSB = (const bf16*)(ws + WS_WSB); const float* bs = a.in[16]; const float* lng = a.in[13]; const float* lnb = a.in[14];
    LAS float* stat = (LAS float*)lds;
    LAS bf16* vnT = (LAS bf16*)(lds + 1024);
    constexpr int VP = 136;
    for (int chunk = BID; chunk < M / 128; chunk += GRD) {
        const size_t R0 = (size_t)chunk * 128;
#pragma unroll
        for (int bt = 0; bt < 2; ++bt) { v4u w0[8], w1[8];
#pragma unroll
            for (int i = 0; i < 8; ++i) { const v4u* vp = (const v4u*)(V + (R0 + wave * 16 + bt * 8 + i) * D + lane * 16); w0[i] = vp[0]; w1[i] = vp[1]; }
            float q1[8], q2[8];
#pragma unroll
            for (int i = 0; i < 8; ++i) { const float x0 = bflo(w0[i].x), x1 = bfhi(w0[i].x), x2 = bflo(w0[i].y), x3 = bfhi(w0[i].y), x4 = bflo(w0[i].z), x5 = bfhi(w0[i].z), x6 = bflo(w0[i].w), x7 = bfhi(w0[i].w);
                const float y0 = bflo(w1[i].x), y1 = bfhi(w1[i].x), y2 = bflo(w1[i].y), y3 = bfhi(w1[i].y), y4 = bflo(w1[i].z), y5 = bfhi(w1[i].z), y6 = bflo(w1[i].w), y7 = bfhi(w1[i].w);
                q1[i] = (((x0 + x1) + (x2 + x3)) + ((x4 + x5) + (x6 + x7))) + (((y0 + y1) + (y2 + y3)) + ((y4 + y5) + (y6 + y7)));
                q2[i] = (((x0 * x0 + x1 * x1) + (x2 * x2 + x3 * x3)) + ((x4 * x4 + x5 * x5) + (x6 * x6 + x7 * x7))) + (((y0 * y0 + y1 * y1) + (y2 * y2 + y3 * y3)) + ((y4 * y4 + y5 * y5) + (y6 * y6 + y7 * y7))); }
#pragma unroll
            for (int o = 1; o < 64; o <<= 1)
#pragma unroll
                for (int i = 0; i < 8; ++i) { q1[i] += __shfl_xor(q1[i], o); q2[i] += __shfl_xor(q2[i], o); }
            if (lane == 0) {
#pragma unroll
                for (int i = 0; i < 8; ++i) { const float mean = q1[i] * (1.f / D); const float var = q2[i] * (1.f / D) - mean * mean; const int r = wave * 16 + bt * 8 + i; stat[2 * r] = mean; stat[2 * r + 1] = 1.f / sqrtf(fmaxf(var, 0.f) + LN_EPS); } } }
        __syncthreads();
        for (int g = 0; g < 8; ++g) {
#pragma unroll
            for (int it = 0; it < 4; ++it) { const int idx = it * 512 + tid, s = idx & 127, dc = idx >> 7;
                const v4u w = *(const v4u*)(V + (R0 + s) * D + g * 128 + dc * 8);
                const float mean = stat[2 * s], rstd = stat[2 * s + 1];
                const f32x4 g0 = *(const f32x4*)(lng + g * 128 + dc * 8), g1 = *(const f32x4*)(lng + g * 128 + dc * 8 + 4), b0 = *(const f32x4*)(lnb + g * 128 + dc * 8), b1 = *(const f32x4*)(lnb + g * 128 + dc * 8 + 4);
                LAS bf16* o = vnT + (dc * 8) * VP + s;
                o[0 * VP] = (bf16)f2bf((bflo(w.x) - mean) * rstd * g0[0] + b0[0]); o[1 * VP] = (bf16)f2bf((bfhi(w.x) - mean) * rstd * g0[1] + b0[1]);
                o[2 * VP] = (bf16)f2bf((bflo(w.y) - mean) * rstd * g0[2] + b0[2]); o[3 * VP] = (bf16)f2bf((bfhi(w.y) - mean) * rstd * g0[3] + b0[3]);
                o[4 * VP] = (bf16)f2bf((bflo(w.z) - mean) * rstd * g1[0] + b1[0]); o[5 * VP] = (bf16)f2bf((bfhi(w.z) - mean) * rstd * g1[1] + b1[1]);
                o[6 * VP] = (bf16)f2bf((bflo(w.w) - mean) * rstd * g1[2] + b1[2]); o[7 * VP] = (bf16)f2bf((bfhi(w.w) - mean) * rstd * g1[3] + b1[3]); }
            __syncthreads();
            const int t0 = wave * 16, nks = (t0 + 15) / 32 + 1, fr = lane & 15, fq = lane >> 4;
            bf16x8 wf[4];
#pragma unroll
            for (int ks = 0; ks < 4; ++ks) wf[ks] = (ks < nks) ? *(const bf16x8*)(WSB + ((size_t)g * 128 + t0 + fr) * 128 + ks * 32 + fq * 8) : (bf16x8){0, 0, 0, 0, 0, 0, 0, 0};
            const float bst = bs[g * 128 + t0 + fr];
#pragma unroll
            for (int dt = 0; dt < 8; ++dt) { f32x4 acc = {0.f, 0.f, 0.f, 0.f};
#pragma unroll
                for (int ks = 0; ks < 4; ++ks) if (ks < nks) { const bf16x8 af = *(const LAS bf16x8*)(vnT + (dt * 16 + fr) * VP + ks * 32 + fq * 8); acc = __builtin_amdgcn_mfma_f32_16x16x32_bf16(af, wf[ks], acc, 0, 0, 0); }
                const size_t off = (R0 + t0 + fr) * D + g * 128 + dt * 16 + fq * 4;
                const v2u uw = *(const v2u*)(U + off); v2u o;
                o.x = pk2(bflo(uw.x) * (acc[0] + bst), bfhi(uw.x) * (acc[1] + bst)); o.y = pk2(bflo(uw.y) * (acc[2] + bst), bfhi(uw.y) * (acc[3] + bst));
                *(v2u*)(Y + off) = o; }
            __syncthreads();
        }
    }
}
#ifndef EXP
#define EXP 0
#endif
__device__ __forceinline__ void attn_phase(const Args& a, unsigned char* lds_generic) {
    const int BID = lbid(), GRD = lgrid();
    unsigned char* ws = a.ws;
    const attn_body::bf16* Q = (const attn_body::bf16*)(ws + WS_R); const attn_body::bf16* K = (const attn_body::bf16*)(ws + WS_R + 64 * MiB); const attn_body::bf16* V = (const attn_body::bf16*)(ws + WS_R + 128 * MiB);
    attn_body::bf16* O = (attn_body::bf16*)(ws + WS_XB1); attn_body::bf16* PO = (attn_body::bf16*)a.out; float* PL = (float*)(ws + WS_PL);
    const float* CB = (const float*)(ws + WS_CB); const unsigned* LST = (const unsigned*)(ws + WS_LST); const unsigned* LEN = (const unsigned*)(ws + WS_LEN);
    int tid = threadIdx.x; asm volatile("" : "+v"(tid)); const int lane = tid & 63, r32 = lane & 31; const int wid = __builtin_amdgcn_readfirstlane(tid >> 6);
    const int G = GRD, bx = BID; const int vcu = (G % 8 == 0) ? (bx % 8) * (G / 8) + bx / 8 : bx;
    constexpr int DMh = attn_body::DM;
    typedef __attribute__((address_space(3))) int lds_int;
    lds_int* offs = (lds_int*)((__attribute__((address_space(3))) unsigned char*)lds_generic + attn_body::LDS_BYTES);
    lds_int* wtot = offs + 1032;
    { const int c0 = (int)((LEN[2 * tid] + 255u) >> 8), c1 = (int)((LEN[2 * tid + 1] + 255u) >> 8); const int mine = c0 + c1; int inc = mine;
#pragma unroll
      for (int o = 1; o < 64; o <<= 1) { const int n = __shfl_up(inc, o); if (lane >= o) inc += n; }
      if (lane == 63) wtot[wid] = inc;
      __syncthreads();
      int base = inc - mine; for (int w = 0; w < wid; ++w) base += wtot[w];
      offs[2 * tid] = base; offs[2 * tid + 1] = base + c0; if (tid == 511) offs[1024] = base + mine;
      __syncthreads(); }
    const int nsel = offs[1024], FOXN = (EXP == 10 ? 2048 : 1024), total = FOXN + 1024 + nsel;
    const int* TMIN = (const int*)(ws + WS_LEN) + 1024; unsigned* qctr = (unsigned*)ws + 3600;
    for (;;) {
        int qo_ = 1048; asm volatile("" : "+s"(qo_)); lds_int* qslot = offs + qo_;
        int tl_ = tid; asm volatile("" : "+v"(tl_)); const int r32 = tl_ & 31; const int wid = __builtin_amdgcn_readfirstlane(tl_ >> 6);
        if (tid == 0) qslot[0] = (int)__hip_atomic_fetch_add(qctr, 1u, __ATOMIC_RELAXED, __HIP_MEMORY_SCOPE_AGENT);
        __syncthreads();
        const int idx = qslot[0];
        if (idx >= total) break;
        if (idx < FOXN) {
            const int qb = 31 - ((idx & 1023) >> 5), bh8 = idx & 31; const int b = bh8 >> 3, h = 8 + (bh8 & 7); const size_t rowbase = (size_t)b * S; const int q0 = qb * 256;
            const int NT = 4 * qb + 4, NTs = NT - TMIN[bh8 * 32 + qb];
            attn_body::attn_unit<8, 0>(Q + (rowbase + q0 + wid * 32 + r32) * DMh + h * 64, K + rowbase * DMh + h * 64, V + rowbase * DMh + h * 64, NT, NTs, (char*)lds_generic,
                                       CB + (size_t)bh8 * S, 0u, nullptr, h, O + (rowbase + q0 + wid * 32) * DMh + h * 64, -1, nullptr, nullptr, 0);
        } else if (idx < FOXN + nsel) {
            const int u = idx - FOXN; int lo = 0, hi_ = 1023;
            while (lo < hi_) { const int mid = (lo + hi_ + 1) >> 1; if (offs[mid] <= u) lo = mid; else hi_ = mid - 1; }
            const int li = lo, c = u - offs[li]; const int bh8 = li >> 5, n = li & 31; const int b = bh8 >> 3, h = bh8 & 7; const size_t rowbase = (size_t)b * S;
            const int len = (int)LEN[li]; const int e = c * 256 + wid * 32 + r32; const bool valid = e < len;
            const unsigned ent = LST[(size_t)li * 8192 + (valid ? e : 0)]; const int t = (int)(ent & 0xffffu), slot = (int)(ent >> 16);
            attn_body::attn_unit<8, 2>(Q + (rowbase + t) * DMh + h * 64, K + (rowbase + n * 256) * DMh + h * 64, V + (rowbase + n * 256) * DMh + h * 64, 4, 4, (char*)lds_generic,
                                       nullptr, 0u, a.in[10], h, nullptr, valid ? (int)(((size_t)bh8 * S + t) * 4 + slot) : -1, PO, PL, t - n * 256);
        } else {
            const int u = idx - FOXN - nsel; const int bh8 = u >> 5, blk = u & 31; const int b = bh8 >> 3, h = bh8 & 7; const size_t rowbase = (size_t)b * S; const int t = blk * 256 + wid * 32 + r32;
            attn_body::attn_unit<8, 1>(Q + (rowbase + t) * DMh + h * 64, K + (rowbase + blk * 256) * DMh + h * 64, V + (rowbase + blk * 256) * DMh + h * 64, 4, 4, (char*)lds_generic,
                                       nullptr, 1u, a.in[10], h, nullptr, (int)(((size_t)bh8 * S + t) * 4), PO, PL, 0);
        }
    }
}

#define XB_TMO      128
#define XB_XCNT(j)  (256  + 64 * (j))
#define XB_XSUB(j)  (1280 + 64 * (j))
#define XB_XGEN(j)  (2304 + 64 * (j))
#define XB_TOP      3328
#define XB_TOPGEN   3392
#define XCD_BAR_WORDS 3456
#define XB_SPIN_CAP (1u << 18)

__device__ __forceinline__ unsigned xb_ld(unsigned* p)              { return __hip_atomic_load(p, __ATOMIC_RELAXED, __HIP_MEMORY_SCOPE_AGENT); }
__device__ __forceinline__ unsigned xb_add(unsigned* p, unsigned v) { return __hip_atomic_fetch_add(p, v, __ATOMIC_RELAXED, __HIP_MEMORY_SCOPE_AGENT); }
__device__ __forceinline__ unsigned xb_xcc_id() { return (unsigned)__builtin_amdgcn_s_getreg((3 << 11) | 20) & 0xFu; }
#define XB_SPIN(cond, bar) do { unsigned _sp = 0; while (cond) { __builtin_amdgcn_s_sleep(24); \
    if ((++_sp & 255u) == 0u) { if (xb_ld(&(bar)[XB_TMO])) break; if (_sp > XB_SPIN_CAP) { atomicAdd(&(bar)[XB_TMO], 1u); break; } } } } while (0)

struct XcdBarrier {
    unsigned* bar; unsigned x;
    volatile LAS unsigned* st;
};

__device__ __forceinline__ XcdBarrier xcd_barrier_post(unsigned* bar, volatile LAS unsigned* st) {
    XcdBarrier b; b.bar = bar; b.x = xb_xcc_id(); b.st = st;
    if (threadIdx.x == 0) (void)xb_add(&bar[XB_XCNT(b.x)], 1u);
    return b;
}
__device__ __forceinline__ void xcd_barrier_complete(unsigned* bar, unsigned x, unsigned& nloc, unsigned& nx) {
    const unsigned G = gridDim.x * gridDim.y * gridDim.z;
    unsigned sum, cnt, mine, sp = 0u;
    for (;;) {
        sum = 0u; cnt = 0u; mine = 0u;
#pragma unroll
        for (unsigned j = 0; j < 16; ++j) { const unsigned c = xb_ld(&bar[XB_XCNT(j)]); sum += c; cnt += (c > 0u) ? 1u : 0u; mine = (j == x) ? c : mine; }
        if (sum == G) break;
        __builtin_amdgcn_s_sleep(1);
        if ((++sp & 255u) == 0u) { if (xb_ld(&bar[XB_TMO])) break; if (sp > XB_SPIN_CAP) { atomicAdd(&bar[XB_TMO], 1u); break; } }
    }
    nloc = mine > 0u ? mine : 1u; nx = cnt > 0u ? cnt : 1u;
}

__device__ __forceinline__ void xcd_barrier(const XcdBarrier& b) {
    asm volatile("s_waitcnt vmcnt(0)" ::: "memory");
    __syncthreads();
    if (threadIdx.x == 0) {
        unsigned* bar = b.bar;
        __builtin_amdgcn_s_waitcnt(0);
        unsigned nloc = b.st[0], nx = b.st[1];
        if (nloc == 0u) { xcd_barrier_complete(bar, b.x, nloc, nx); b.st[0] = nloc; b.st[1] = nx; }
        const unsigned old = xb_add(&bar[XB_XSUB(b.x)], 1u);
        const unsigned gen = old / nloc;
        if (old + 1u == (gen + 1u) * nloc) {
            __builtin_amdgcn_fence(__ATOMIC_RELEASE, "agent");
            asm volatile("s_waitcnt vmcnt(0)" ::: "memory");
            const unsigned og = xb_add(&bar[XB_TOP], 1u);
            const unsigned tg = og / nx;
            if (og + 1u == (tg + 1u) * nx) xb_add(&bar[XB_TOPGEN], 1u);
            else XB_SPIN(xb_ld(&bar[XB_TOPGEN]) == tg, bar);
            __builtin_amdgcn_fence(__ATOMIC_ACQUIRE, "agent");
            xb_add(&bar[XB_XGEN(b.x)], 1u);
            asm volatile("s_waitcnt vmcnt(0)" ::: "memory");
        } else {
            XB_SPIN(xb_ld(&bar[XB_XGEN(b.x)]) == gen, bar);
            __builtin_amdgcn_fence(__ATOMIC_ACQUIRE, "agent");
            asm volatile("s_waitcnt vmcnt(0)" ::: "memory");
        }
    }
    __syncthreads();
}

__global__ void __launch_bounds__(NWAVES * 64, 2) mega_fwd(Args a0) {
    extern __shared__ __attribute__((aligned(16))) unsigned char lds[];
    LAS unsigned char* L = (LAS unsigned char*)lds;
    const int tid = threadIdx.x, lane = tid & 63, wave = __builtin_amdgcn_readfirstlane(tid >> 6);
    cg::grid_group grid = cg::this_grid();
    volatile LAS unsigned* MISC = (volatile LAS unsigned*)(L + 131072);
    if (threadIdx.x < 16) MISC[threadIdx.x] = 0u;
    __syncthreads();
    unsigned* const barw = (unsigned*)a0.ws;
    XcdBarrier bar; bar.bar = barw; bar.x = 0; bar.st = nullptr;
    int ph = 0; const int ph_lo = a0.ph_lo, ph_hi = a0.ph_hi;
#define PHASE_BEGIN if (ph >= ph_lo && ph < ph_hi) { int tid = threadIdx.x; asm volatile("" : "+v"(tid)); const int lane = tid & 63, wave = __builtin_amdgcn_readfirstlane(tid >> 6); (void)lane; (void)wave; const int BID = lbid(), G = lgrid(); (void)BID; (void)G; \
    const __attribute__((address_space(4))) Args* kp_ = (const __attribute__((address_space(4))) Args*)__builtin_amdgcn_kernarg_segment_ptr(); asm volatile("" : "+s"(kp_)); Args a; _Pragma("unroll") for (int i_ = 0; i_ < 20; ++i_) a.in[i_] = kp_->in[i_]; a.out = kp_->out; a.ws = kp_->ws; a.ph_lo = 0; a.ph_hi = 0; \
    unsigned char* ws = a.ws; float* XF = a.out; bf16* XB = (bf16*)(ws + WS_XB); bf16* XB1 = (bf16*)(ws + WS_XB1); bf16* R = (bf16*)(ws + WS_R); LAS unsigned char* XL = L + 131072 + 1024; (void)XF; (void)XB; (void)XB1; (void)R; (void)XL; \
    const float* CSV = (const float*)(ws + WS_CS); const float* LCB = (const float*)(ws + WS_LCB); (void)CSV; (void)LCB;
#define PHASE_END if (ph + 1 < ph_hi) { if (ph == 0) { grid.sync(); bar = xcd_barrier_post(barw, MISC + 8); } else xcd_barrier(bar); } } ++ph;
#define SPI(k) ((float*)(ws + WS_SP + (size_t)(k) * SP_SZ))
#define LNG(li, k) (a.in[2] + ((li) * 3 + (k)) * D)
#define LNB(li, k) (a.in[3] + ((li) * 3 + (k)) * D)
#define GEMM_RUN(EPI, Aptr, Bptr, N_, K_, ...) GEMM_RUN_X(EPI, Aptr, Bptr, N_, K_, K_, K_, 128L, 128L, __VA_ARGS__)
#define GEMM_RUN_LD(EPI, Aptr, Bptr, N_, K_, LDA_, LDB_, ...) GEMM_RUN_X(EPI, Aptr, Bptr, N_, K_, 64, 64, (long)M * 128L, (long)(N_) * 128L, __VA_ARGS__)
#define GEMM_RUN_X(EPI, Aptr, Bptr, N_, K_, LDA_, LDB_, KSA_, KSB_, ...) { pg8::Gemm g{(const bf16*)(Aptr), (const bf16*)(Bptr), M, (N_), (K_), (LDA_), (LDB_), (KSA_), (KSB_)}; pg8::StaticOrder so; so.init(M, (N_), G, BID); EPI E{__VA_ARGS__}; pg8::gemm_phase<EPI, pg8::StaticOrder, true, true>(L, g, so, E); }
#define FFN_UP(LNFLAG, Aptr, mat, spk, csoff) GEMM_RUN(pg8::EpiSwiglu<LNFLAG>, Aptr, ws + WS_WGU + (size_t)(mat) * SZ_WGU, 2 * FF, D, R, M, SPI(spk), CSV + (csoff), LCB + (csoff))
#ifndef EXP
#define EXP 0
#endif
#define REPEAT_IF(c) for (int rep_ = 0; rep_ < ((c) ? 2 : 1); ++rep_)
    PHASE_BEGIN p0_prologue(a, L, tid, lane, wave); PHASE_END
    if (EXP == 4) { for (int i_ = 0; i_ < 50; ++i_) xcd_barrier(bar); }
    PHASE_BEGIN finalize_cs(a, tid, lane, wave); FFN_UP(false, XB, 0, 0, 0) PHASE_END
    REPEAT_IF(EXP == 7) { if (rep_) --ph; PHASE_BEGIN GEMM_RUN_LD(pg8::EpiResid<0>, R, ws + WS_WD + 0 * SZ_WD, D, FF, HP, FF, a.in[0], nullptr, XB, DN_ALPHA, 0.5f, nullptr, nullptr, nullptr, SPI(0), XL) PHASE_END }
    if (EXP == 20) { --ph; PHASE_BEGIN GEMM_RUN_LD(pg8::EpiBf16<0>, R, ws + WS_WD + 0 * SZ_WD, D, FF, HP, FF, XB1, D, nullptr, 0, 0, 1.f) PHASE_END }
    if (EXP == 21) { --ph; PHASE_BEGIN GEMM_RUN(pg8::EpiBf16<0>, XB, ws + WS_WOUT, D, D, XB1, D, nullptr, 0, 0, 1.f) PHASE_END }
    REPEAT_IF(EXP == 8) { if (rep_) --ph; PHASE_BEGIN logits_job(a, XB, lane, wave);
        GEMM_RUN(pg8::EpiQKV, XB, ws + WS_WIN, 3072, D, R, (size_t)(64 * MiB) / 2, attn_body::C2, (float*)(ws + WS_KBAR), SPI(0), CSV + CS_WIN, LCB + CS_WIN) PHASE_END }
    PHASE_BEGIN prep_phase(a, L, tid, lane, wave); PHASE_END
    REPEAT_IF(EXP == 13) { if (rep_) --ph; PHASE_BEGIN lists_phase(a, tid, lane, wave); PHASE_END }
    PHASE_BEGIN attn_phase(a, lds); PHASE_END
    REPEAT_IF(EXP == 14) { if (rep_) --ph; PHASE_BEGIN combine_phase(a, tid); PHASE_END }
    PHASE_BEGIN GEMM_RUN(pg8::EpiResid<1>, XB1, ws + WS_WOUT, D, D, nullptr, XB, XB, DN_ALPHA, 1.0f, SPI(0), LNG(0, 0), LNB(0, 0), SPI(1), XL) PHASE_END
    PHASE_BEGIN FFN_UP(true, XB, 1, 1, CS_WGU01) PHASE_END
    PHASE_BEGIN GEMM_RUN(pg8::EpiBf16<0>, ws + WS_PB, ws + WS_WPP, D, PLE, XB1, D, nullptr, 0, 0, 1.f)
        GEMM_RUN_LD(pg8::EpiResid<1>, R, ws + WS_WD + 1 * SZ_WD, D, FF, HP, FF, nullptr, XB, XB, DN_ALPHA, 0.5f, SPI(1), LNG(0, 1), LNB(0, 1), SPI(2), XL) PHASE_END
    PHASE_BEGIN GEMM_RUN(pg8::EpiPle<false>, XB, ws + WS_WPG, D, D, XB, nullptr, XB1, SPI(2), CSV + CS_WPG0, LCB + CS_WPG0, LNG(0, 2), LNB(0, 2)) PHASE_END
    PHASE_BEGIN FFN_UP(false, XB1, 2, 0, 0) PHASE_END
    PHASE_BEGIN GEMM_RUN_LD(pg8::EpiResid<2>, R, ws + WS_WD + 2 * SZ_WD, D, FF, HP, FF, nullptr, XB1, XB, DN_ALPHA, 0.5f, nullptr, nullptr, nullptr, SPI(3), XL) PHASE_END
    PHASE_BEGIN GEMM_RUN(pg8::EpiSguIn, XB, ws + WS_WSIN, 2048, D, R, (bf16*)(ws + WS_R + 64 * MiB), a.in[12], SPI(3), CSV + CS_WSIN, LCB + CS_WSIN, nullptr, XL) PHASE_END
    REPEAT_IF(EXP == 6) { if (rep_) --ph; PHASE_BEGIN sgu_mix_phase(a, L, tid, lane, wave); PHASE_END }
    PHASE_BEGIN GEMM_RUN(pg8::EpiResid<1>, ws + WS_R + 128 * MiB, ws + WS_WSOUT, D, D, nullptr, XB, XB, DN_ALPHA, 1.0f, SPI(3), LNG(1, 0), LNB(1, 0), SPI(4), XL) PHASE_END
    PHASE_BEGIN FFN_UP(true, XB, 3, 4, CS_WGU11) PHASE_END
    PHASE_BEGIN GEMM_RUN(pg8::EpiBf16<0>, ws + WS_PB + (size_t)M * PLE * 2, ws + WS_WPP + (size_t)D * PLE * 2, D, PLE, XB1, D, nullptr, 0, 0, 1.f)
        GEMM_RUN_LD(pg8::EpiResid<1>, R, ws + WS_WD + 3 * SZ_WD, D, FF, HP, FF, nullptr, XB, XB, DN_ALPHA, 0.5f, SPI(4), LNG(1, 1), LNB(1, 1), SPI(5), XL) PHASE_END
    PHASE_BEGIN GEMM_RUN(pg8::EpiPle<true>, XB, ws + WS_WPG + (size_t)D * D * 2, D, D, XB, XF, XB1, SPI(5), CSV + CS_WPG1, LCB + CS_WPG1, LNG(1, 2), LNB(1, 2)) PHASE_END
#undef PHASE_BEGIN
#undef PHASE_END
}
constexpr int N_PHASES = 20;

#ifndef MK_PER_PHASE
#define MK_PER_PHASE 0
#endif
extern "C" void kernel_launch(void* const* d_in, const int* in_sizes, int n_in, void* d_out, int out_size, void* d_ws, size_t ws_size, hipStream_t stream) {
    static int grid = 0;
    if (grid == 0) {
        if (n_in != 20 || out_size != M * D || ws_size < WS_END) { fprintf(stderr, "kernel_launch: unexpected shapes (n_in %d out %d ws %zu)\n", n_in, out_size, ws_size); grid = -1; return; }
        int dev = 0, cus = 0, per_cu = 0;
        hipGetDevice(&dev); hipDeviceGetAttribute(&cus, hipDeviceAttributeMultiprocessorCount, dev);
        if (hipFuncSetAttribute((const void*)mega_fwd, hipFuncAttributeMaxDynamicSharedMemorySize, LDS_BYTES) != hipSuccess) { fprintf(stderr, "kernel_launch: hipFuncSetAttribute failed\n"); grid = -1; return; }
        if (hipOccupancyMaxActiveBlocksPerMultiprocessor(&per_cu, (const void*)mega_fwd, NWAVES * 64, LDS_BYTES) != hipSuccess || per_cu < 1) { fprintf(stderr, "kernel_launch: occupancy query says %d\n", per_cu); per_cu = 1; }
        (void)hipGetLastError();
        grid = cus * per_cu;
        fprintf(stderr, "kernel_launch: grid %d (cus %d x %d)\n", grid, cus, per_cu);
    }
    if (grid < 0) return;
    Args a{};
    for (int i = 0; i < 20; ++i) a.in[i] = (const float*)d_in[i];
    a.out = (float*)d_out; a.ws = (unsigned char*)d_ws;
#if MK_PER_PHASE
    for (int p = 0; p < N_PHASES; ++p) { a.ph_lo = p; a.ph_hi = p + 1; hipLaunchKernelGGL(mega_fwd, dim3(grid), dim3(NWAVES * 64), LDS_BYTES, stream, a); }
#else
    a.ph_lo = 0; a.ph_hi = N_PHASES;
    void* args[] = {&a};
    hipError_t e = hipLaunchCooperativeKernel((const void*)mega_fwd, dim3(grid), dim3(NWAVES * 64), args, LDS_BYTES, stream);
    if (e != hipSuccess) fprintf(stderr, "cooperative launch failed: %s (grid %d)\n", hipGetErrorString(e), grid);
#endif
}
```

```cpp
#include <hip/hip_runtime.h>
#include <cstdio>
#include <cstdint>
__device__ __forceinline__ int lbid() { int b = blockIdx.x; asm volatile("" : "+s"(b)); return b; }
__device__ __forceinline__ int lgrid() { int g = gridDim.x; asm volatile("" : "+s"(g)); return g; }
namespace pg8 {
#define PG8_LAS __attribute__((address_space(3)))
typedef unsigned short bf16_t;
typedef short bf16x8 __attribute__((ext_vector_type(8)));
typedef float f32x4 __attribute__((ext_vector_type(4)));
typedef unsigned u32x4 __attribute__((ext_vector_type(4)));
constexpr int BM = 256, BK = 64, HALF = 128, HTB = HALF * BK * 2  , STAGE_BYTES = 8 * HTB, NXCD = 8, WGM = 4;

__host__ __device__ __forceinline__ int lds_byte(int r, int c) { const int st = (r >> 4) * 2 + (c >> 5), rr = r & 15, cc = c & 31, ob = rr * 64 + cc * 2; return st * 1024 + (ob ^ (((ob >> 9) & 1) << 5)); }
__host__ __device__ __forceinline__ void stage_rc(int b, int& R, int& C) { const int st = b / 1024, sb = b % 1024, swz = sb ^ (((sb >> 9) & 1) << 5); R = (st >> 1) * 16 + swz / 64; C = (st & 1) * 32 + (swz % 64) / 2; }
__host__ __device__ __forceinline__ int perm32(int rho) { const int n = rho >> 4, i = rho & 15; return 8 * (i >> 2) + 4 * n + (i & 3); }

struct Unit { int pm, pn; };
struct Gemm { const bf16_t* A; const bf16_t* Bt; int M, N, K, lda, ldb; long kstepA, kstepB; };

struct StaticOrder {
    int nM, nN, nwg, G, c;
    __host__ __device__ void init(int M, int N, int G_, int c_) { nM = M / BM; nN = N / BM; nwg = nM * nN; G = G_; c = c_; }
    __host__ __device__ bool next(int i, Unit& u) const {
        const long L = (long)i * G + c; if (L >= nwg) return false;
        int wgid = (int)L; { const int q = nwg / NXCD, r = nwg % NXCD, xcd = wgid % NXCD, off = wgid / NXCD; wgid = (xcd < r ? xcd * (q + 1) : r * (q + 1) + (xcd - r) * q) + off; }
        const int nig = WGM * nN, gid = wgid / nig, fm = gid * WGM, gsz = (nM - fm) < WGM ? (nM - fm) : WGM;
        u.pm = fm + ((wgid % nig) % gsz); u.pn = (wgid % nig) / gsz; return true;
    }
    __device__ __forceinline__ void a_ready(const Unit&) const {}
    __device__ __forceinline__ void done(const Unit&) const {}
};

__device__ __forceinline__ unsigned cvt_pk_bf16(float lo, float hi) { unsigned r; asm("v_cvt_pk_bf16_f32 %0, %1, %2" : "=v"(r) : "v"(lo), "v"(hi)); return r; }
typedef float f32x2 __attribute__((ext_vector_type(2)));
__device__ __forceinline__ f32x2 gelu_pk(f32x2 v) {
    const f32x2 av = __builtin_elementwise_abs(v), d = av * 0.2316418882f + 1.0f;
    f32x2 t; t.x = __builtin_amdgcn_rcpf(d.x); t.y = __builtin_amdgcn_rcpf(d.y);
    f32x2 q = t * 0.5307027145f + (-0.7265760135f); q = q * t + 0.7107068705f; q = q * t + (-0.142248368f); q = q * t + 0.127414796f; q = q * t;
    const f32x2 s = (v * v) * (-0.72134752044f);
    f32x2 e; e.x = __builtin_amdgcn_exp2f(s.x); e.y = __builtin_amdgcn_exp2f(s.y);
    const f32x2 m = v * (q * e), r = v - m;
    f32x2 o; o.x = v.x < 0.f ? m.x : r.x; o.y = v.y < 0.f ? m.y : r.y; return o;
}

template <int ACT  > struct EpiBf16 {
    static constexpr bool PERM = true, AFTER_DRAIN = false; static_assert(ACT == 0 || ACT == 1, "EpiBf16: ACT is 0 (none) or 1 (gelu_pk)");
    bf16_t* O; int ldc; const float* bias; int split_cols; size_t split_stride; float scale0;
    __device__ __forceinline__ void operator()(const f32x4 (&acc)[2][2][4][2], const Unit& u, int wr, int wc, int fr_in, int fq_in) const {
        int fr = fr_in, fq = fq_in; asm volatile("" : "+v"(fr), "+v"(fq));
        const int row0 = u.pm * BM + wr * 64 + fr; int colt = u.pn * BM; bf16_t* base = O;
        float sc = 1.f; if (split_cols) { const int t = colt / split_cols; base += (size_t)t * split_stride; colt -= t * split_cols; if (t == 0) sc = scale0; }
        const int col0 = colt + wc * 32 + 8 * fq, bcol0 = u.pn * BM + wc * 32 + 8 * fq;
        f32x4 bv[2][2];
#pragma unroll
        for (int bj = 0; bj < 2; ++bj)
#pragma unroll
            for (int n = 0; n < 2; ++n) bv[bj][n] = bias ? *(const f32x4*)(bias + bcol0 + bj * HALF + 4 * n) : (f32x4){0.f, 0.f, 0.f, 0.f};
#pragma unroll
        for (int ai = 0; ai < 2; ++ai)
#pragma unroll
            for (int m = 0; m < 4; ++m) { bf16_t* rowp = base + (size_t)(row0 + ai * HALF + m * 16) * ldc + col0;
#pragma unroll
                for (int bj = 0; bj < 2; ++bj) { f32x4 v0 = acc[ai][bj][m][0] + bv[bj][0], v1 = acc[ai][bj][m][1] + bv[bj][1];
                    if (ACT == 1) { f32x2 a = gelu_pk((f32x2){v0[0], v0[1]}), b = gelu_pk((f32x2){v0[2], v0[3]}), c = gelu_pk((f32x2){v1[0], v1[1]}), d = gelu_pk((f32x2){v1[2], v1[3]});
                        v0 = (f32x4){a.x, a.y, b.x, b.y}; v1 = (f32x4){c.x, c.y, d.x, d.y}; }
                    v0 = v0 * sc; v1 = v1 * sc; u32x4 w; w.x = cvt_pk_bf16(v0[0], v0[1]); w.y = cvt_pk_bf16(v0[2], v0[3]); w.z = cvt_pk_bf16(v1[0], v1[1]); w.w = cvt_pk_bf16(v1[2], v1[3]);
                    *(u32x4*)(rowp + bj * HALF) = w; } }
    }
};
__device__ __forceinline__ float fast_sigmoid(float v) { return __builtin_amdgcn_rcpf(1.0f + __builtin_amdgcn_exp2f(-1.4426950408889634f * v)); }
__device__ __forceinline__ float gelu_tanh(float v) { const float u = 0.7978845608028654f * (v + 0.044715f * v * v * v); return v * fast_sigmoid(2.0f * u); }
struct RowStats { float mu[2][4], rs[2][4]; };
__device__ __forceinline__ void load_row_stats(const float* sp, int row0, RowStats& r) {
#pragma unroll
    for (int ai = 0; ai < 2; ++ai) { asm volatile("" ::: "memory");
#pragma unroll
        for (int m = 0; m < 4; ++m) { const float* p = sp + (size_t)(row0 + ai * HALF + m * 16) * 8; const f32x4 a = *(const f32x4*)p, b = *(const f32x4*)(p + 4);
            const float s1 = (a[0] + a[2]) + (b[0] + b[2]), s2 = (a[1] + a[3]) + (b[1] + b[3]); const float mu = s1 * (1.f / 1024.f); const float var = s2 * (1.f / 1024.f) - mu * mu;
            r.mu[ai][m] = mu; r.rs[ai][m] = __builtin_amdgcn_rsqf(__builtin_fmaxf(var, 0.f) + 1e-5f); } }
}
__device__ __forceinline__ f32x4 ln_fix(const f32x4& a, float mu, float rs, const f32x4& cs, const f32x4& cb) { return (a - cs * mu) * rs + cb; }
__device__ __forceinline__ void emit_row_stats(float (&s1)[2][4], float (&s2)[2][4], float* sp_new, const Unit& u, int wr, int wc, int fr, int fq, PG8_LAS unsigned char* xl) {
    typedef float f32x2v __attribute__((ext_vector_type(2)));
    PG8_LAS f32x2v* P = (PG8_LAS f32x2v*)xl;
#pragma unroll
    for (int ai = 0; ai < 2; ++ai)
#pragma unroll
        for (int m = 0; m < 4; ++m) { float a = s1[ai][m], b = s2[ai][m]; a += __shfl_xor(a, 16); b += __shfl_xor(b, 16); a += __shfl_xor(a, 32); b += __shfl_xor(b, 32);
            if (fq == 0) P[(ai * HALF + wr * 64 + m * 16 + fr) * 4 + wc] = (f32x2v){a, b}; }
    asm volatile("s_waitcnt lgkmcnt(0)" ::: "memory"); __builtin_amdgcn_s_barrier(); asm volatile("" ::: "memory");
    const int tid = (wr * 4 + wc) * 64 + fq * 16 + fr;
    if (tid < 256) { const f32x2v a = P[tid * 4 + 0], b = P[tid * 4 + 1], c = P[tid * 4 + 2], d = P[tid * 4 + 3];
        f32x2v o; o.x = (a.x + b.x) + (c.x + d.x); o.y = (a.y + b.y) + (c.y + d.y);
        *(f32x2v*)(sp_new + ((size_t)(u.pm * BM + tid) * 4 + u.pn) * 2) = o; }
    asm volatile("s_waitcnt lgkmcnt(0)" ::: "memory"); __builtin_amdgcn_s_barrier(); asm volatile("" ::: "memory");
}
template <bool LN> struct EpiSwiglu {
    static constexpr bool PERM = true, AFTER_DRAIN = false;
    bf16_t* H; int mrows; const float* sp; const float* cs; const float* cb;
    __device__ __forceinline__ void operator()(const f32x4 (&acc)[2][2][4][2], const Unit& u, int wr, int wc, int fr_in, int fq_in) const {
        int fr = fr_in, fq = fq_in; asm volatile("" : "+v"(fr), "+v"(fq));
        const int row0 = u.pm * BM + wr * 64 + fr, n0 = u.pn * BM + wc * 32 + 8 * fq; const int kt = u.pn * 2 + (wc >> 1), cin = (wc & 1) * 32 + 8 * fq;
        RowStats rst; f32x4 csv[2][2], cbv[2][2];
        if constexpr (LN) { load_row_stats(sp, row0, rst);
#pragma unroll
            for (int bj = 0; bj < 2; ++bj)
#pragma unroll
                for (int n = 0; n < 2; ++n) { csv[bj][n] = *(const f32x4*)(cs + n0 + bj * HALF + 4 * n); cbv[bj][n] = *(const f32x4*)(cb + n0 + bj * HALF + 4 * n); } }
#pragma unroll
        for (int ai = 0; ai < 2; ++ai)
#pragma unroll
            for (int m = 0; m < 4; ++m) { bf16_t* rowp = H + ((size_t)kt * mrows + (row0 + ai * HALF + m * 16)) * 64 + cin;
                float h[8];
#pragma unroll
                for (int n = 0; n < 2; ++n) { f32x4 g = acc[ai][0][m][n], uu = acc[ai][1][m][n];
                    if constexpr (LN) { g = ln_fix(g, rst.mu[ai][m], rst.rs[ai][m], csv[0][n], cbv[0][n]); uu = ln_fix(uu, rst.mu[ai][m], rst.rs[ai][m], csv[1][n], cbv[1][n]); }
#pragma unroll
                    for (int j = 0; j < 4; ++j) h[4 * n + j] = g[j] * fast_sigmoid(g[j]) * uu[j]; }
                u32x4 w; w.x = cvt_pk_bf16(h[0], h[1]); w.y = cvt_pk_bf16(h[2], h[3]); w.z = cvt_pk_bf16(h[4], h[5]); w.w = cvt_pk_bf16(h[6], h[7]);
                *(u32x4*)rowp = w; }
    }
};
__device__ __forceinline__ float bf_lo(unsigned w) { return __uint_as_float(w << 16); }
__device__ __forceinline__ float bf_hi(unsigned w) { return __uint_as_float(w & 0xffff0000u); }
template <int BASE> struct EpiResid {
    static constexpr bool PERM = true, AFTER_DRAIN = false;
    const float* basef; const bf16_t* baseb; bf16_t* zb; float alpha, s; const float* sp_old; const float* lg; const float* lb; float* sp_new; PG8_LAS unsigned char* xl;
    __device__ __forceinline__ void operator()(const f32x4 (&acc)[2][2][4][2], const Unit& u, int wr, int wc, int fr_in, int fq_in) const {
        int fr = fr_in, fq = fq_in; asm volatile("" : "+v"(fr), "+v"(fq));
        const int row0 = u.pm * BM + wr * 64 + fr, col0 = u.pn * BM + wc * 32 + 8 * fq;
        float al_ = alpha, s_ = s; asm volatile("" : "+v"(al_), "+v"(s_));
        RowStats rst;
        if constexpr (BASE == 1) load_row_stats(sp_old, row0, rst);
        float s1[2][4], s2[2][4];
#pragma unroll
        for (int ai = 0; ai < 2; ++ai)
#pragma unroll
            for (int m = 0; m < 4; ++m) { s1[ai][m] = 0.f; s2[ai][m] = 0.f; }
#pragma unroll
        for (int bj = 0; bj < 2; ++bj) { f32x4 gv[2], bv[2];
            if constexpr (BASE == 1) {
#pragma unroll
                for (int n = 0; n < 2; ++n) { gv[n] = *(const f32x4*)(lg + col0 + bj * HALF + 4 * n); bv[n] = *(const f32x4*)(lb + col0 + bj * HALF + 4 * n); } }
#pragma unroll
            for (int ai = 0; ai < 2; ++ai) {
                f32x4 pf[4][2]; u32x4 pb[4];
#pragma unroll
                for (int m = 0; m < 4; ++m) { const size_t off = (size_t)(row0 + ai * HALF + m * 16) * 1024 + col0 + bj * HALF;
                    if constexpr (BASE == 0) { pf[m][0] = *(const f32x4*)(basef + off); pf[m][1] = *(const f32x4*)(basef + off + 4); } else pb[m] = *(const u32x4*)(baseb + off); }
#pragma unroll
                for (int m = 0; m < 4; ++m) { const size_t off = (size_t)(row0 + ai * HALF + m * 16) * 1024 + col0 + bj * HALF; f32x4 b[2];
                    if constexpr (BASE == 0) { b[0] = pf[m][0]; b[1] = pf[m][1]; }
                    else { const u32x4 pw = pb[m]; b[0] = (f32x4){bf_lo(pw.x), bf_hi(pw.x), bf_lo(pw.y), bf_hi(pw.y)}; b[1] = (f32x4){bf_lo(pw.z), bf_hi(pw.z), bf_lo(pw.w), bf_hi(pw.w)}; }
                    f32x4 z[2];
#pragma unroll
                    for (int n = 0; n < 2; ++n) { if constexpr (BASE == 1) b[n] = (b[n] - rst.mu[ai][m]) * rst.rs[ai][m] * gv[n] + bv[n];
                        z[n] = b[n] * al_ + acc[ai][bj][m][n] * s_; }
                    u32x4 w; w.x = cvt_pk_bf16(z[0][0], z[0][1]); w.y = cvt_pk_bf16(z[0][2], z[0][3]); w.z = cvt_pk_bf16(z[1][0], z[1][1]); w.w = cvt_pk_bf16(z[1][2], z[1][3]);
                    *(u32x4*)(zb + off) = w;
                    const float r0 = bf_lo(w.x), r1 = bf_hi(w.x), r2 = bf_lo(w.y), r3 = bf_hi(w.y), r4 = bf_lo(w.z), r5 = bf_hi(w.z), r6 = bf_lo(w.w), r7 = bf_hi(w.w);
                    s1[ai][m] += ((r0 + r1) + (r2 + r3)) + ((r4 + r5) + (r6 + r7)); s2[ai][m] += ((r0 * r0 + r1 * r1) + (r2 * r2 + r3 * r3)) + ((r4 * r4 + r5 * r5) + (r6 * r6 + r7 * r7)); }
                asm volatile("" ::: "memory"); } }
        emit_row_stats(s1, s2, sp_new, u, wr, wc, fr, fq, xl);
    }
};
struct EpiQKV {
    static constexpr bool PERM = true, AFTER_DRAIN = false;
    bf16_t* O; size_t split_stride; float scale0; float* kbar; const float* sp; const float* cs; const float* cb;
    __device__ __forceinline__ void operator()(const f32x4 (&acc)[2][2][4][2], const Unit& u, int wr, int wc, int fr_in, int fq_in) const {
        int fr = fr_in, fq = fq_in; asm volatile("" : "+v"(fr), "+v"(fq));
        const int row0 = u.pm * BM + wr * 64 + fr; const int t = u.pn >> 2; bf16_t* base = O + (size_t)t * split_stride; const float sc = (t == 0) ? scale0 : 1.f;
        const int col0 = (u.pn & 3) * BM + wc * 32 + 8 * fq, n0 = u.pn * BM + wc * 32 + 8 * fq;
        RowStats rst; load_row_stats(sp, row0, rst); f32x4 csv[2][2], cbv[2][2];
#pragma unroll
        for (int bj = 0; bj < 2; ++bj)
#pragma unroll
            for (int n = 0; n < 2; ++n) { csv[bj][n] = *(const f32x4*)(cs + n0 + bj * HALF + 4 * n); cbv[bj][n] = *(const f32x4*)(cb + n0 + bj * HALF + 4 * n); }
        const bool kb = (u.pn == 4 || u.pn == 5);
        f32x4 ks[2][2];
#pragma unroll
        for (int bj = 0; bj < 2; ++bj)
#pragma unroll
            for (int n = 0; n < 2; ++n) ks[bj][n] = (f32x4){0.f, 0.f, 0.f, 0.f};
#pragma unroll
        for (int ai = 0; ai < 2; ++ai)
#pragma unroll
            for (int m = 0; m < 4; ++m) { bf16_t* rowp = base + (size_t)(row0 + ai * HALF + m * 16) * 1024 + col0;
#pragma unroll
                for (int bj = 0; bj < 2; ++bj) { const f32x4 v0r = ln_fix(acc[ai][bj][m][0], rst.mu[ai][m], rst.rs[ai][m], csv[bj][0], cbv[bj][0]), v1r = ln_fix(acc[ai][bj][m][1], rst.mu[ai][m], rst.rs[ai][m], csv[bj][1], cbv[bj][1]);
                    ks[bj][0] += v0r; ks[bj][1] += v1r; const f32x4 v0 = v0r * sc, v1 = v1r * sc;
                    u32x4 w; w.x = cvt_pk_bf16(v0[0], v0[1]); w.y = cvt_pk_bf16(v0[2], v0[3]); w.z = cvt_pk_bf16(v1[0], v1[1]); w.w = cvt_pk_bf16(v1[2], v1[3]);
                    *(u32x4*)(rowp + bj * HALF) = w; } }
        if (kb) {
            const int colt = (u.pn - 4) * BM + wc * 32 + 8 * fq; const int b = u.pm >> 5, blk = u.pm & 31;
#pragma unroll
            for (int bj = 0; bj < 2; ++bj)
#pragma unroll
                for (int n = 0; n < 2; ++n)
#pragma unroll
                    for (int j = 0; j < 4; ++j) { float s = ks[bj][n][j];
                        s += __shfl_xor(s, 1); s += __shfl_xor(s, 2); s += __shfl_xor(s, 4); s += __shfl_xor(s, 8);
                        if (fr == 0) { const int col = colt + bj * HALF + 4 * n + j; atomicAdd(kbar + ((size_t)((b * 8 + (col >> 6)) * 32 + blk)) * 64 + (col & 63), s); } }
        }
    }
};
struct EpiSguIn {
    static constexpr bool PERM = true, AFTER_DRAIN = false;
    bf16_t* U; bf16_t* V; const float* bias; const float* sp; const float* cs; const float* cb; float* spv; PG8_LAS unsigned char* xl;
    __device__ __forceinline__ void operator()(const f32x4 (&acc)[2][2][4][2], const Unit& u, int wr, int wc, int fr_in, int fq_in) const {
        int fr = fr_in, fq = fq_in; asm volatile("" : "+v"(fr), "+v"(fq));
        const int row0 = u.pm * BM + wr * 64 + fr; const int t = u.pn >> 2; bf16_t* base = t ? V : U;
        const int col0 = (u.pn & 3) * BM + wc * 32 + 8 * fq, n0 = u.pn * BM + wc * 32 + 8 * fq;
        RowStats rst; load_row_stats(sp, row0, rst);
#pragma unroll
        for (int bj = 0; bj < 2; ++bj) { f32x4 csv[2], cbv[2];
#pragma unroll
            for (int n = 0; n < 2; ++n) { csv[n] = *(const f32x4*)(cs + n0 + bj * HALF + 4 * n); cbv[n] = *(const f32x4*)(cb + n0 + bj * HALF + 4 * n) + *(const f32x4*)(bias + n0 + bj * HALF + 4 * n); }
#pragma unroll
            for (int ai = 0; ai < 2; ++ai)
#pragma unroll
                for (int m = 0; m < 4; ++m) { bf16_t* rowp = base + (size_t)(row0 + ai * HALF + m * 16) * 1024 + col0 + bj * HALF;
                    f32x4 v0 = ln_fix(acc[ai][bj][m][0], rst.mu[ai][m], rst.rs[ai][m], csv[0], cbv[0]), v1 = ln_fix(acc[ai][bj][m][1], rst.mu[ai][m], rst.rs[ai][m], csv[1], cbv[1]);
#pragma unroll
                    for (int j = 0; j < 4; ++j) { v0[j] = gelu_tanh(v0[j]); v1[j] = gelu_tanh(v1[j]); }
                    u32x4 w; w.x = cvt_pk_bf16(v0[0], v0[1]); w.y = cvt_pk_bf16(v0[2], v0[3]); w.z = cvt_pk_bf16(v1[0], v1[1]); w.w = cvt_pk_bf16(v1[2], v1[3]);
                    *(u32x4*)rowp = w; } }
    }
};
template <bool FINAL> struct EpiPle {
    static constexpr bool PERM = true, AFTER_DRAIN = false;
    const bf16_t* zb; float* outf; bf16_t* pexb; const float* sp; const float* cs; const float* cb; const float* lg; const float* lb;
    __device__ __forceinline__ void operator()(const f32x4 (&acc)[2][2][4][2], const Unit& u, int wr, int wc, int fr_in, int fq_in) const {
        int fr = fr_in, fq = fq_in; asm volatile("" : "+v"(fr), "+v"(fq));
        const int row0 = u.pm * BM + wr * 64 + fr, col0 = u.pn * BM + wc * 32 + 8 * fq;
        RowStats rst; load_row_stats(sp, row0, rst);
#pragma unroll
        for (int bj = 0; bj < 2; ++bj) { f32x4 csv[2], cbv[2], gv[2], bv[2];
#pragma unroll
            for (int n = 0; n < 2; ++n) { csv[n] = *(const f32x4*)(cs + col0 + bj * HALF + 4 * n); cbv[n] = *(const f32x4*)(cb + col0 + bj * HALF + 4 * n); gv[n] = *(const f32x4*)(lg + col0 + bj * HALF + 4 * n); bv[n] = *(const f32x4*)(lb + col0 + bj * HALF + 4 * n); }
#pragma unroll
            for (int am = 0; am < (FINAL ? 8 : 4); ++am) { constexpr int GR = FINAL ? 1 : 2; const int ai = (am * GR) >> 2; u32x4 ppw[4], pzw[4];
#pragma unroll
                for (int m = (am * GR) & 3; m < ((am * GR) & 3) + GR; ++m) { const size_t off = (size_t)(row0 + ai * HALF + m * 16) * 1024 + col0 + bj * HALF; ppw[m] = *(const u32x4*)(pexb + off); pzw[m] = *(const u32x4*)(zb + off); }
                asm volatile("" ::: "memory");
#pragma unroll
                for (int m = (am * GR) & 3; m < ((am * GR) & 3) + GR; ++m) { const size_t off = (size_t)(row0 + ai * HALF + m * 16) * 1024 + col0 + bj * HALF; const float mu = rst.mu[ai][m], rs = rst.rs[ai][m];
                    const u32x4 pw = ppw[m]; const u32x4 zw = pzw[m];
                    const f32x4 x0 = ((f32x4){bf_lo(zw.x), bf_hi(zw.x), bf_lo(zw.y), bf_hi(zw.y)} - mu) * rs * gv[0] + bv[0], x1 = ((f32x4){bf_lo(zw.z), bf_hi(zw.z), bf_lo(zw.w), bf_hi(zw.w)} - mu) * rs * gv[1] + bv[1];
                    const f32x4 a0 = ln_fix(acc[ai][bj][m][0], mu, rs, csv[0], cbv[0]), a1 = ln_fix(acc[ai][bj][m][1], mu, rs, csv[1], cbv[1]); f32x4 o0, o1;
                    o0[0] = x0[0] + fast_sigmoid(a0[0]) * bf_lo(pw.x); o0[1] = x0[1] + fast_sigmoid(a0[1]) * bf_hi(pw.x);
                    o0[2] = x0[2] + fast_sigmoid(a0[2]) * bf_lo(pw.y); o0[3] = x0[3] + fast_sigmoid(a0[3]) * bf_hi(pw.y);
                    o1[0] = x1[0] + fast_sigmoid(a1[0]) * bf_lo(pw.z); o1[1] = x1[1] + fast_sigmoid(a1[1]) * bf_hi(pw.z);
                    o1[2] = x1[2] + fast_sigmoid(a1[2]) * bf_lo(pw.w); o1[3] = x1[3] + fast_sigmoid(a1[3]) * bf_hi(pw.w);
                    if constexpr (FINAL) { *(f32x4*)(outf + off) = o0; *(f32x4*)(outf + off + 4) = o1; }
                    else { u32x4 w; w.x = cvt_pk_bf16(o0[0], o0[1]); w.y = cvt_pk_bf16(o0[2], o0[3]); w.z = cvt_pk_bf16(o1[0], o1[1]); w.w = cvt_pk_bf16(o1[2], o1[3]); *(u32x4*)(pexb + off) = w; } } } }
    }
};
template <class Epi, class Sched, bool ALIGN_EPI = false, bool SP2 = false>
__device__ __forceinline__ void gemm_phase(PG8_LAS unsigned char* lds, const Gemm g, const Sched& S, const Epi& E) {
    int tid = threadIdx.x; asm volatile("" : "+v"(tid));
    const int wid = __builtin_amdgcn_readfirstlane(tid >> 6), lane = tid & 63, wr = wid >> 2, wc = wid & 3, fr = lane & 15, fq = lane >> 4;
    int K = g.K; asm volatile("" : "+s"(K)); const int nt = K / BK; const int lda = g.lda, ldb = g.ldb;
    unsigned voffA[2], voffB[2];
#pragma unroll
    for (int i = 0; i < 2; ++i) { int R, C; stage_rc(tid * 16 + i * 8192, R, C); const int Rb = Epi::PERM ? ((R & ~31) + perm32(R & 31)) : R;
        voffA[i] = (unsigned)(R * lda + C) * 2u; voffB[i] = (unsigned)(Rb * ldb + C) * 2u; }
    const long kstep = g.kstepB; const long kstepA = g.kstepA;
    const size_t hstepA = (size_t)HALF * lda * 2, hstepB = (size_t)HALF * ldb * 2;
    const size_t tstepA = 2 * hstepA, tstepB = 2 * hstepB;
    const unsigned ldsw = (unsigned)wid * 1024u;
    const int aoff = lds_byte(wr * 64 + fr, fq * 8), boff = lds_byte(wc * 32 + fr, fq * 8);
#define PG8_SA(b, h) (((b) * 2 + (h)) * HTB)
#define PG8_SB(b, h) ((4 + (b) * 2 + (h)) * HTB)
#define PG8_STAGE(bufoff, gbase, voff) do { _Pragma("unroll") for (int _i = 0; _i < 2; ++_i) \
        __builtin_amdgcn_global_load_lds((const unsigned*)((const char*)(gbase) + (voff)[_i]), (PG8_LAS unsigned*)(lds + (bufoff) + ldsw + _i * 8192), 16, 0, 0); } while (0)
#define PG8_LDA(dst, b, h) do { _Pragma("unroll") for (int m = 0; m < 4; ++m) _Pragma("unroll") for (int k = 0; k < 2; ++k) dst[m][k] = *(const PG8_LAS bf16x8*)(lds + PG8_SA(b, h) + aoff + m * 2048 + k * 1024); } while (0)
#define PG8_LDB(dst, b, h) do { _Pragma("unroll") for (int n = 0; n < 2; ++n) _Pragma("unroll") for (int k = 0; k < 2; ++k) dst[n][k] = *(const PG8_LAS bf16x8*)(lds + PG8_SB(b, h) + boff + n * 2048 + k * 1024); } while (0)
#define PG8_MMA(ai, bj, At, Bt) do { __builtin_amdgcn_s_setprio(1); _Pragma("unroll") for (int m = 0; m < 4; ++m) _Pragma("unroll") for (int n = 0; n < 2; ++n) _Pragma("unroll") for (int k = 0; k < 2; ++k) \
        acc[ai][bj][m][n] = __builtin_amdgcn_mfma_f32_16x16x32_bf16(Bt[n][k], At[m][k], acc[ai][bj][m][n], 0, 0, 0); __builtin_amdgcn_s_setprio(0); } while (0)
#define PG8_WAIT_V(n) asm volatile("s_waitcnt vmcnt(" #n ")" ::: "memory")
#define PG8_WAIT_L(n) asm volatile("s_waitcnt lgkmcnt(" #n ")" ::: "memory")
#define PG8_BAR __builtin_amdgcn_s_barrier()
#define PG8_SCHED __builtin_amdgcn_sched_barrier(0)
    Unit cur, nxt; int ui = 0;
    if (!S.next(0, cur)) return;
    f32x4 acc[2][2][4][2];
#pragma unroll
    for (int a = 0; a < 2; ++a)
#pragma unroll
        for (int b = 0; b < 2; ++b)
#pragma unroll
            for (int m = 0; m < 4; ++m)
#pragma unroll
                for (int n = 0; n < 2; ++n) acc[a][b][m][n] = (f32x4){0.f, 0.f, 0.f, 0.f};
    bf16x8 At[4][2], B0[2][2], B1[2][2];
    const char* cA = (const char*)g.A + (size_t)cur.pm * tstepA; const char* cB = (const char*)g.Bt + (size_t)cur.pn * tstepB;
    S.a_ready(cur);
    if constexpr (SP2) {
        PG8_STAGE(PG8_SB(0, 0), cB, voffB); PG8_STAGE(PG8_SB(0, 1), cB + hstepB, voffB); PG8_STAGE(PG8_SA(0, 0), cA, voffA); PG8_STAGE(PG8_SA(0, 1), cA + hstepA, voffA);
        if (wr == 1) PG8_BAR;
        PG8_WAIT_V(2); PG8_BAR;
        PG8_STAGE(PG8_SB(1, 0), cB + kstep, voffB); PG8_STAGE(PG8_SA(1, 0), cA + kstepA, voffA); PG8_STAGE(PG8_SB(1, 1), cB + hstepB + kstep, voffB);
        PG8_WAIT_V(6); PG8_BAR;
    } else {
        PG8_STAGE(PG8_SB(0, 0), cB, voffB); PG8_STAGE(PG8_SA(0, 0), cA, voffA); PG8_STAGE(PG8_SB(0, 1), cB + hstepB, voffB); PG8_STAGE(PG8_SA(0, 1), cA + hstepA, voffA);
        if (wr == 1) PG8_BAR;
        PG8_WAIT_V(4); PG8_BAR;
        PG8_STAGE(PG8_SB(1, 0), cB + kstep, voffB); PG8_STAGE(PG8_SA(1, 0), cA + kstepA, voffA); PG8_STAGE(PG8_SB(1, 1), cB + hstepB + kstep, voffB);
        PG8_WAIT_V(6); PG8_BAR;
    }
    for (;;) {
        const bool has_next = S.next(ui + 1, nxt);
        const char* nA = has_next ? (const char*)g.A + (size_t)nxt.pm * tstepA : cA; const char* nB = has_next ? (const char*)g.Bt + (size_t)nxt.pn * tstepB : cB;
        for (int t = 0; t < nt; t += 2) {
            const bool last = (t == nt - 2);
            const char* a1 = cA + (long)(t + 1) * kstepA;
            const char* a2 = last ? nA : cA + (long)(t + 2) * kstepA; const char* b2 = last ? nB : cB + (long)(t + 2) * kstep;
            const char* a3 = a2 + kstepA; const char* b3 = b2 + kstep;
            if (last && has_next) S.a_ready(nxt);
            if constexpr (SP2) {
            PG8_LDB(B0, 0, 0); PG8_LDB(B1, 0, 1); PG8_SCHED; PG8_LDA(At, 0, 0); PG8_STAGE(PG8_SA(1, 1), a1 + hstepA, voffA);
            PG8_WAIT_V(8); PG8_WAIT_L(0); PG8_BAR; PG8_MMA(0, 0, At, B0); PG8_MMA(0, 1, At, B1); PG8_BAR; PG8_SCHED;
            PG8_LDA(At, 0, 1); PG8_STAGE(PG8_SB(0, 0), b2, voffB); PG8_STAGE(PG8_SB(0, 1), b2 + hstepB, voffB); PG8_STAGE(PG8_SA(0, 0), a2, voffA);
            PG8_WAIT_V(8); PG8_WAIT_L(0); PG8_BAR; PG8_MMA(1, 0, At, B0); PG8_MMA(1, 1, At, B1); PG8_BAR; PG8_SCHED;
            PG8_LDB(B0, 1, 0); PG8_LDB(B1, 1, 1); PG8_SCHED; PG8_LDA(At, 1, 0); PG8_STAGE(PG8_SA(0, 1), a2 + hstepA, voffA);
            PG8_WAIT_V(8); PG8_WAIT_L(0); PG8_BAR; PG8_MMA(0, 0, At, B0); PG8_MMA(0, 1, At, B1); PG8_BAR; PG8_SCHED;
            PG8_LDA(At, 1, 1); PG8_STAGE(PG8_SB(1, 0), b3, voffB); PG8_STAGE(PG8_SB(1, 1), b3 + hstepB, voffB); PG8_STAGE(PG8_SA(1, 0), a3, voffA);
            PG8_WAIT_V(8); PG8_WAIT_L(0); PG8_BAR; PG8_MMA(1, 0, At, B0); PG8_MMA(1, 1, At, B1); PG8_BAR; PG8_SCHED;
            } else {
            PG8_LDB(B0, 0, 0); PG8_SCHED; PG8_LDA(At, 0, 0); PG8_STAGE(PG8_SA(1, 1), a1 + hstepA, voffA);
            PG8_WAIT_L(8); PG8_BAR; PG8_WAIT_L(0); PG8_MMA(0, 0, At, B0); PG8_BAR; PG8_SCHED;
            PG8_LDB(B1, 0, 1); PG8_STAGE(PG8_SB(0, 0), b2, voffB);
            PG8_BAR; PG8_WAIT_L(0); PG8_MMA(0, 1, At, B1); PG8_BAR;
            PG8_LDA(At, 0, 1); PG8_STAGE(PG8_SA(0, 0), a2, voffA);
            PG8_BAR; PG8_WAIT_L(0); PG8_MMA(1, 0, At, B0); PG8_BAR; PG8_SCHED;
            PG8_STAGE(PG8_SB(0, 1), b2 + hstepB, voffB);
            PG8_WAIT_V(6); PG8_BAR; PG8_MMA(1, 1, At, B1); PG8_BAR;
            PG8_LDB(B0, 1, 0); PG8_SCHED; PG8_LDA(At, 1, 0); PG8_STAGE(PG8_SA(0, 1), a2 + hstepA, voffA);
            PG8_WAIT_L(8); PG8_BAR; PG8_WAIT_L(0); PG8_MMA(0, 0, At, B0); PG8_BAR; PG8_SCHED;
            PG8_LDB(B1, 1, 1); PG8_STAGE(PG8_SB(1, 0), b3, voffB);
            PG8_BAR; PG8_WAIT_L(0); PG8_MMA(0, 1, At, B1); PG8_BAR;
            PG8_LDA(At, 1, 1); PG8_STAGE(PG8_SA(1, 0), a3, voffA);
            PG8_BAR; PG8_WAIT_L(0); PG8_MMA(1, 0, At, B0); PG8_BAR; PG8_SCHED;
            PG8_STAGE(PG8_SB(1, 1), b3 + hstepB, voffB);
            PG8_WAIT_V(6); PG8_BAR; PG8_MMA(1, 1, At, B1); PG8_BAR;
            }
        }
        if constexpr (ALIGN_EPI) { if (wr == 0) PG8_BAR; }
        if constexpr (!Epi::AFTER_DRAIN) { E(acc, cur, wr, wc, fr, fq); S.done(cur); }
        if (!has_next) break;
#pragma unroll
        for (int a = 0; a < 2; ++a)
#pragma unroll
            for (int b = 0; b < 2; ++b)
#pragma unroll
                for (int m = 0; m < 4; ++m)
#pragma unroll
                    for (int n = 0; n < 2; ++n) acc[a][b][m][n] = (f32x4){0.f, 0.f, 0.f, 0.f};
        cur = nxt; cA = nA; cB = nB; ++ui;
        if constexpr (ALIGN_EPI) { if (wr == 1) PG8_BAR; }
    }
    PG8_WAIT_V(0);
    if constexpr (!ALIGN_EPI) { if (wr == 0) PG8_BAR; }
    PG8_BAR;
    if constexpr (Epi::AFTER_DRAIN) { E.fused(acc, cur, wr, wc, fr, fq, lds, wid, lane); S.done(cur); }
#undef PG8_SA
#undef PG8_SB
#undef PG8_STAGE
#undef PG8_LDA
#undef PG8_LDB
#undef PG8_MMA
#undef PG8_WAIT_V
#undef PG8_WAIT_L
#undef PG8_BAR
#undef PG8_SCHED
}
}
#include <hip/hip_bf16.h>
#include <cmath>
namespace attn_body {
using bf16=__hip_bfloat16;
using bf16x8=__attribute__((ext_vector_type(8)))short;
using s16x4=__attribute__((ext_vector_type(4)))short;
using f32x16=__attribute__((ext_vector_type(16)))float;
using u32x4=__attribute__((ext_vector_type(4)))unsigned;
using f32x4v=__attribute__((ext_vector_type(4)))float;
constexpr int BATCH=4,NHEAD=16,SEQ=8192,D=64,DM=NHEAD*D;
constexpr int NW=8,QBLK=32,QB=QBLK*NW,KVBLK=64,NQB=SEQ/QB;
constexpr int ATTN_PITCH=DM, ATTN_UNIT_ROWS=QB;
__device__ __forceinline__ int crow(int r,int hi){return (r&3)+8*(r>>2)+4*hi;}
#define SBAR() __builtin_amdgcn_sched_barrier(0)
__device__ __forceinline__ void cmask(f32x16&p0,f32x16&p1,int jb,int qrel,int hi){
  const float NEG=-INFINITY; int kb=64*jb+4*hi;
  #pragma unroll
  for(int r=0;r<16;++r){int kv=kb+(r&3)+8*(r>>2); if(kv>qrel)p0[r]=NEG; if(kv+32>qrel)p1[r]=NEG;}
}

constexpr int NSLOT=3, SLOTB=8192;
constexpr int LDS_K=0, LDS_V=NSLOT*SLOTB, LDS_WS=2*NSLOT*SLOTB, LDS_OST=LDS_WS+NW*64*4, LDS_RB=LDS_OST+NW*4096, LDS_CB=LDS_RB+1024, LDS_BYTES=LDS_CB+SEQ*4;
constexpr float C2=0.125f*1.4426950408889634f;
__device__ __forceinline__ void glds16(const void*gsrc,unsigned lds_dst){unsigned keep;
  asm volatile("s_mov_b32 %0, m0\n\ts_mov_b32 m0, %2\n\ts_nop 0\n\tglobal_load_lds_dwordx4 %1, off\n\ts_mov_b32 m0, %0":"=&s"(keep):"v"(gsrc),"s"(lds_dst):"memory");}
__device__ __forceinline__ float max3f(float a,float b,float c){float r;asm("v_max3_f32 %0, %1, %2, %3":"=v"(r):"v"(a),"v"(b),"v"(c));return r;}
__device__ __forceinline__ float max2f(float a,float b){float r;asm("v_max_f32_e32 %0, %1, %2":"=v"(r):"v"(a),"v"(b));return r;}
__device__ __forceinline__ float fadd_s(float a,float b){float r;asm("v_add_f32_e32 %0, %1, %2":"=v"(r):"v"(a),"v"(b));return r;}
__device__ __forceinline__ float fsub_s(float a,float b){float r;asm("v_sub_f32_e32 %0, %1, %2":"=v"(r):"v"(a),"v"(b));return r;}
typedef float f32x2_t __attribute__((ext_vector_type(2))); typedef __bf16 bf16x2_t __attribute__((ext_vector_type(2)));
__device__ __forceinline__ unsigned cvtpk_s(float lo,float hi){f32x2_t v={lo,hi};bf16x2_t b=__builtin_convertvector(v,bf16x2_t);return __builtin_bit_cast(unsigned,b);}
#define WAIT_BAR(N) asm volatile("s_waitcnt vmcnt(" #N ") lgkmcnt(0)\n\ts_barrier":::"memory")

__device__ __forceinline__ void qkt(f32x16&p0,f32x16&p1,const char*Kslot,const bf16x8*qr,const f32x16&negm,int r32,int hi){
  const char*kb=Kslot+hi*1024+r32*16;
  #pragma unroll
  for(int d0=0;d0<4;++d0){
    const bf16x8 b0=*reinterpret_cast<const bf16x8*>(kb+d0*2048);
    const bf16x8 b1=*reinterpret_cast<const bf16x8*>(kb+d0*2048+512);
    if(d0==0){p0=__builtin_amdgcn_mfma_f32_32x32x16_bf16(b0,qr[0],negm,0,0,0);p1=__builtin_amdgcn_mfma_f32_32x32x16_bf16(b1,qr[0],negm,0,0,0);}
    else{p0=__builtin_amdgcn_mfma_f32_32x32x16_bf16(b0,qr[d0],p0,0,0,0);p1=__builtin_amdgcn_mfma_f32_32x32x16_bf16(b1,qr[d0],p1,0,0,0);}}
}
typedef __attribute__((address_space(3))) const char* lds_cptr;
typedef short v4i16_t __attribute__((ext_vector_type(4)));
__device__ __forceinline__ void kload8(bf16x8*kf,lds_cptr kp){
  kf[0]=*(const __attribute__((address_space(3))) bf16x8*)(kp);      kf[1]=*(const __attribute__((address_space(3))) bf16x8*)(kp+512);
  kf[2]=*(const __attribute__((address_space(3))) bf16x8*)(kp+2048); kf[3]=*(const __attribute__((address_space(3))) bf16x8*)(kp+2560);
  kf[4]=*(const __attribute__((address_space(3))) bf16x8*)(kp+4096); kf[5]=*(const __attribute__((address_space(3))) bf16x8*)(kp+4608);
  kf[6]=*(const __attribute__((address_space(3))) bf16x8*)(kp+6144); kf[7]=*(const __attribute__((address_space(3))) bf16x8*)(kp+6656);
}
__device__ __forceinline__ void kload2(bf16x8*kf,lds_cptr kp,int j){ kf[2*j]=*(const __attribute__((address_space(3))) bf16x8*)(kp+j*2048); kf[2*j+1]=*(const __attribute__((address_space(3))) bf16x8*)(kp+j*2048+512); }
__device__ __forceinline__ s16x4 vtr(lds_cptr p){ return __builtin_bit_cast(s16x4,__builtin_amdgcn_ds_read_tr16_b64_v4i16((__attribute__((address_space(3))) v4i16_t*)p)); }
__device__ __forceinline__ float rowmax(const f32x16&p0,const f32x16&p1){
  float a=max3f(p0[0],p0[1],p1[0]),b=max3f(p0[2],p0[3],p1[1]);a=max3f(a,p1[2],p1[3]);
  #pragma unroll
  for(int r=4;r<16;r+=4){a=max3f(a,p0[r],p0[r+1]);b=max3f(b,p0[r+2],p0[r+3]);a=max3f(a,p1[r],p1[r+1]);b=max3f(b,p1[r+2],p1[r+3]);}
  const float m=max2f(a,b);
  auto rr=__builtin_amdgcn_permlane32_swap(__float_as_uint(m),__float_as_uint(m),false,false);
  return max2f(__uint_as_float(rr[0]),__uint_as_float(rr[1]));
}
__device__ __forceinline__ void pv(f32x16*o,int vb,bf16x8 pa0,bf16x8 pa1,bf16x8 pa2,bf16x8 pa3){
  #pragma unroll
  for(int d0=0;d0<2;++d0){s16x4 lo[4],hi[4];
    #pragma unroll
    for(int ks=0;ks<4;++ks){
      asm volatile("ds_read_b64_tr_b16 %0,%1 offset:%c2":"=&v"(lo[ks]):"v"(vb),"i"(d0*4096+ks*1024):"memory");
      asm volatile("ds_read_b64_tr_b16 %0,%1 offset:%c2":"=&v"(hi[ks]):"v"(vb),"i"(d0*4096+ks*1024+512):"memory");}
    asm volatile("s_waitcnt lgkmcnt(0)":::"memory");SBAR();
    #define PK(k) (bf16x8){lo[k][0],lo[k][1],lo[k][2],lo[k][3],hi[k][0],hi[k][1],hi[k][2],hi[k][3]}
    o[d0]=__builtin_amdgcn_mfma_f32_32x32x16_bf16(pa0,PK(0),o[d0],0,0,0);
    o[d0]=__builtin_amdgcn_mfma_f32_32x32x16_bf16(pa1,PK(1),o[d0],0,0,0);
    o[d0]=__builtin_amdgcn_mfma_f32_32x32x16_bf16(pa2,PK(2),o[d0],0,0,0);
    o[d0]=__builtin_amdgcn_mfma_f32_32x32x16_bf16(pa3,PK(3),o[d0],0,0,0);
    #undef PK
  }
}

#ifndef ATTN_STORE16
#define ATTN_STORE16(p,v) (*(u32x4*)(p)=(v))
#endif
template<int KIND> __device__ __forceinline__ f32x16 mk_negt(const f32x16&negm,float mhat,unsigned selw,int t){ if constexpr(KIND!=1){return negm;} else { const float v=((selw>>(t>>2))&1u)?-mhat:-1e30f; f32x16 x; _Pragma("unroll") for(int r=0;r<16;++r)x[r]=v; return x; } }
template<int THRL,int KIND> __device__ __forceinline__ void attn_unit(const bf16*Qlane,const bf16*__restrict__ Kh,const bf16*__restrict__ Vh,const int NT,const int NTs,char*shm,const float*cbh,const unsigned selw_in,const float*relb,const int h,bf16*Odirect,const int pidx,bf16*PO,float*PL,const int trel){
  int tid=threadIdx.x; asm volatile("":"+v"(tid)); const int lane=tid&63,r32=lane&31,hi=lane>>5; const int wid=__builtin_amdgcn_readfirstlane(tid>>6);
  const unsigned lds0=(unsigned)(uintptr_t)shm;
  float*wsf=(float*)(shm+LDS_WS)+wid*64;
  const bf16*ksrc=Kh+(long)lane*DM+wid*8;
  const bf16*vsrc=Vh+(long)(16*(wid&3)+(lane>>2))*DM+(wid>>2)*32+(lane&3)*8;
  const unsigned kdst=lds0+LDS_K+wid*1024, vdst=lds0+LDS_V+wid*1024;
  #define TI(t) ((KIND==0)?(NT-1-(t)):(t))
  #define DMA_K(t,slot) glds16(ksrc+(long)TI(t)*KVBLK*DM,(unsigned)__builtin_amdgcn_readfirstlane(kdst+(slot)))
  #define DMA_V(t,slot) glds16(vsrc+(long)TI(t)*KVBLK*DM,(unsigned)__builtin_amdgcn_readfirstlane(vdst+(slot)))
  const int vb0=(int)(lds0+LDS_V)+((lane>>4)&1)*32+(lane&3)*8+(4*hi+((lane&15)>>2))*64;
  const char*Kbase=shm+LDS_K; bf16x8 kf[8];
  const lds_cptr shm3=(lds_cptr)shm; const lds_cptr kp0=shm3+LDS_K+hi*1024+r32*16; const lds_cptr vp0=shm3+LDS_V+((lane>>4)&1)*32+(lane&3)*8+(4*hi+((lane&15)>>2))*64;
  DMA_K(0,0);DMA_V(0,0);DMA_K(1,SLOTB);
  bf16x8 qr[4];
  #pragma unroll
  for(int d0=0;d0<4;++d0)qr[d0]=*reinterpret_cast<const bf16x8*>(&Qlane[d0*16+hi*8]);
  float mhat=0.f,l_reg=0.f;f32x16 o[2];o[0]=f32x16{};o[1]=f32x16{};float z0_=0.f; asm volatile("":"+v"(z0_)); f32x16 negm; _Pragma("unroll") for(int r=0;r<16;++r)negm[r]=z0_; asm volatile("":"+v"(negm));
  const int qrel=wid*QBLK+r32;
  #define HKA(P0,P1,t) do{ if constexpr(KIND==0){ const lds_f32* cp_=cbl+64*TI(t)+4*hi; \
      _Pragma("unroll") for(int g_=0;g_<4;++g_){ const f32x4v a_=*(const lds_f32x4*)(cp_+8*g_); const f32x4v b_=*(const lds_f32x4*)(cp_+32+8*g_); \
        _Pragma("unroll") for(int j_=0;j_<4;++j_){ P0[4*g_+j_]+=a_[j_]; P1[4*g_+j_]+=b_[j_]; } } } }while(0)
  #define CMASK(P0,P1,t) do{int jb_=TI(t)-(NT-4); if constexpr(KIND==0){ if(jb_>=0)cmask(P0,P1,jb_,qrel,hi); } else if constexpr(KIND==1){ if(jb_>=-2){ const float NEG_=-INFINITY; const int kb_=64*jb_+4*hi; \
      _Pragma("unroll") for(int r=0;r<16;++r){ const int d0_=qrel-(kb_+(r&3)+8*(r>>2)); const int d1_=d0_-32; \
        const float b0_=rbl[d0_<0?0:(d0_>128?128:d0_)], b1_=rbl[d1_<0?0:(d1_>128?128:d1_)]; \
        P0[r]=d0_<0?NEG_:P0[r]+b0_; P1[r]=d1_<0?NEG_:P1[r]+b1_; } } } \
    else { if(__any(trel<64*(t)+191)){ const int kb_=64*(t)+4*hi; \
      _Pragma("unroll") for(int r=0;r<16;++r){ const int d0_=trel-(kb_+(r&3)+8*(r>>2)); const int d1_=d0_-32; \
        P0[r]+=rbl[d0_>128?128:d0_]; P1[r]+=rbl[d1_>128?128:d1_]; } } } }while(0)
  bool resc=false;
  #define START(P0,P1) do{ const float rm=rowmax(P0,P1); resc=false; \
    { const float dl=__builtin_fmaxf(rm,-64.f); mhat=fadd_s(mhat,dl); \
      _Pragma("unroll") for(int r=0;r<16;++r){P0[r]=fsub_s(P0[r],dl);P1[r]=fsub_s(P1[r],dl);} \
      _Pragma("unroll") for(int r=0;r<16;++r)negm[r]=-mhat; asm volatile("":"+v"(negm)); } \
    _Pragma("unroll") for(int r=0;r<16;++r)P0[r]=__builtin_amdgcn_exp2f(P0[r]); }while(0)
  #define RESC() do{ if(resc){ asm volatile("s_waitcnt lgkmcnt(0)":::"memory"); \
      _Pragma("unroll") for(int d_=0;d_<2;++d_) _Pragma("unroll") for(int r=0;r<16;++r)o[d_][r]*=wsf[crow(r,hi)]; } }while(0)
  f32x16 pA0,pA1,pB0,pB1;
  int sl_prev=0,sl_cur=0,sl_next=SLOTB;
  #define ROT() do{sl_prev=sl_cur;sl_cur=sl_next;sl_next=(sl_next==(NSLOT-1)*SLOTB)?0:sl_next+SLOTB;}while(0)
  DMA_K(2,2*SLOTB);
  typedef __attribute__((address_space(3))) float lds_f32; typedef __attribute__((address_space(3))) f32x4v lds_f32x4;
  lds_f32* const cbl=(lds_f32*)(shm3+LDS_CB); lds_f32* const rbl=(lds_f32*)(shm3+LDS_RB);
  unsigned selw=0u;
  if constexpr(KIND==0){ const int n4=NT*16; for(int i=(NT-NTs)*16+tid;i<n4;i+=512) ((lds_f32x4*)cbl)[i]=((const f32x4v*)cbh)[i]; }
  else { selw=selw_in;
    if(tid<=128){ float v=0.f; if(tid<128){ int bk=tid; if(tid>=16){ bk=16+(int)(__builtin_log2f((float)tid*0.0625f)*(16.f/3.f)); bk=bk>31?31:bk; } v=(relb[bk*8+h]-relb[31*8+h])*1.4426950408889634f; } rbl[tid]=v; } }
  WAIT_BAR(3);
  { const f32x16 negt0=mk_negt<KIND>(negm,mhat,selw,0); qkt(pA0,pA1,Kbase,qr,negt0,r32,hi); }asm volatile("s_nop 15\n\ts_nop 7":"+v"(pA0),"+v"(pA1));HKA(pA0,pA1,0);CMASK(pA0,pA1,0);
  START(pA0,pA1);
  _Pragma("unroll") for(int r=0;r<16;++r)pA1[r]=__builtin_amdgcn_exp2f(pA1[r]);
  WAIT_BAR(0);
  DMA_K(3,0);DMA_V(1,SLOTB);
  ROT();
  kload8(kf,kp0+sl_cur);
  WAIT_BAR(2);
  s16x4 vlo[8],vhi[8]; u32x4 pw0,pw1,pw2,pw3;
  #define PKW(P,B) cvtpk_s(P[B],P[B+1])
  #define PAF(k) __builtin_bit_cast(bf16x8,pw##k)
  #define VFR(i) (bf16x8){vlo[i][0],vlo[i][1],vlo[i][2],vlo[i][3],vhi[i][0],vhi[i][1],vhi[i][2],vhi[i][3]}
  #define PIN(x) asm volatile("":"+v"(x))
  #define MX3(a,b,c) __builtin_fmaxf(__builtin_fmaxf((a),(b)),(c))
  #define GAPA(MF,A0,A1,A2,A3,W0,W1,PW) do{ MF; sacc+=A0; sacc+=A1; sacc+=A2; sacc+=A3; PIN(sacc); W0; W1; PIN(PW); SBAR(); }while(0)
  #define EX(v) __builtin_amdgcn_exp2f(v)
  #define GAPB(MF,X,B) do{ MF; X[B]=EX(X[B]); X[B+1]=EX(X[B+1]); X[B+2]=EX(X[B+2]); X[B+3]=EX(X[B+3]); PIN(X); SBAR(); }while(0)
  #define VRD(i) do{ vlo[i]=vtr(vp_+(((i)>>2)*4096+((i)&3)*1024)); vhi[i]=vtr(vp_+(((i)>>2)*4096+((i)&3)*1024+512)); }while(0)
  #define KRD(G,j) do{ if(G){ kload2(kf,kp0+sl_next,j); SBAR(); } }while(0)
  #define STEP(C0,C1,P0,P1,t,GK,GV,GL) do{ SBAR(); \
    const lds_cptr vp_=vp0+sl_prev; const f32x16 negt_=mk_negt<KIND>(negm,mhat,selw,(t)); \
    VRD(0); SBAR(); float sacc=(P0[0]+P0[1]); \
    GAPA(C0=__builtin_amdgcn_mfma_f32_32x32x16_bf16(kf[0],qr[0],negt_,0,0,0), P0[2],P0[3],P0[4],P0[5],     pw0[0]=PKW(P0,0), pw0[1]=PKW(P0,2), pw0); \
    VRD(4); SBAR(); GAPA(C1=__builtin_amdgcn_mfma_f32_32x32x16_bf16(kf[1],qr[0],negt_,0,0,0), P0[6],P0[7],P0[8],P0[9],     pw0[2]=PKW(P0,4), pw0[3]=PKW(P0,6), pw0); \
    VRD(1); SBAR(); GAPA(C0=__builtin_amdgcn_mfma_f32_32x32x16_bf16(kf[2],qr[1],C0,0,0,0),   P0[10],P0[11],P0[12],P0[13], pw1[0]=PKW(P0,8), pw1[1]=PKW(P0,10), pw1); \
    VRD(5); SBAR(); GAPA(C1=__builtin_amdgcn_mfma_f32_32x32x16_bf16(kf[3],qr[1],C1,0,0,0),   P0[14],P0[15],P1[0],P1[1],   pw1[2]=PKW(P0,12),pw1[3]=PKW(P0,14), pw1); \
    VRD(2); SBAR(); GAPA(C0=__builtin_amdgcn_mfma_f32_32x32x16_bf16(kf[4],qr[2],C0,0,0,0),   P1[2],P1[3],P1[4],P1[5],     pw2[0]=PKW(P1,0), pw2[1]=PKW(P1,2), pw2); \
    VRD(6); SBAR(); GAPA(C1=__builtin_amdgcn_mfma_f32_32x32x16_bf16(kf[5],qr[2],C1,0,0,0),   P1[6],P1[7],P1[8],P1[9],     pw2[2]=PKW(P1,4), pw2[3]=PKW(P1,6), pw2); \
    VRD(3); SBAR(); GAPA(C0=__builtin_amdgcn_mfma_f32_32x32x16_bf16(kf[6],qr[3],C0,0,0,0),   P1[10],P1[11],P1[12],P1[13], pw3[0]=PKW(P1,8), pw3[1]=PKW(P1,10), pw3); \
    VRD(7); SBAR(); GAPA(C1=__builtin_amdgcn_mfma_f32_32x32x16_bf16(kf[7],qr[3],C1,0,0,0),   P1[14],P1[15],0.f,0.f,       pw3[2]=PKW(P1,12),pw3[3]=PKW(P1,14), pw3); \
    l_reg+=sacc; \
    if(GK){DMA_K((t)+3,sl_cur);} if(GV){DMA_V((t)+1,sl_next);} \
    HKA(C0,C1,t); CMASK(C0,C1,t); \
    { float a=MX3(C0[0],C0[1],C1[0]),b=MX3(C0[2],C0[3],C1[1]); a=MX3(a,C1[2],C1[3]); \
      _Pragma("unroll") for(int r=4;r<16;r+=4){a=MX3(a,C0[r],C0[r+1]);b=MX3(b,C0[r+2],C0[r+3]);a=MX3(a,C1[r],C1[r+1]);b=MX3(b,C1[r+2],C1[r+3]);} \
      float rm=__builtin_fmaxf(a,b); { auto rr=__builtin_amdgcn_permlane32_swap(__float_as_uint(rm),__float_as_uint(rm),false,false); rm=__builtin_fmaxf(__uint_as_float(rr[0]),__uint_as_float(rr[1])); } \
      resc=false; \
      if(__builtin_expect(__any(rm>(float)THRL),0)){ const float dl=__builtin_fmaxf(rm,0.f); mhat+=dl; \
        _Pragma("unroll") for(int r=0;r<16;++r){C0[r]-=dl;C1[r]-=dl;} \
        _Pragma("unroll") for(int r=0;r<16;++r)negm[r]=-mhat; asm volatile("":"+v"(negm)); \
        const float f=__builtin_amdgcn_exp2f(-dl); l_reg*=f; if(hi==0)wsf[r32]=f; resc=true; } } \
    SBAR(); \
    GAPB(o[0]=__builtin_amdgcn_mfma_f32_32x32x16_bf16(PAF(0),VFR(0),o[0],0,0,0), C0,0); \
    GAPB(o[1]=__builtin_amdgcn_mfma_f32_32x32x16_bf16(PAF(0),VFR(4),o[1],0,0,0), C0,4); \
    KRD(GL,0); GAPB(o[0]=__builtin_amdgcn_mfma_f32_32x32x16_bf16(PAF(1),VFR(1),o[0],0,0,0), C0,8); \
    KRD(GL,1); GAPB(o[1]=__builtin_amdgcn_mfma_f32_32x32x16_bf16(PAF(1),VFR(5),o[1],0,0,0), C0,12); \
    KRD(GL,2); GAPB(o[0]=__builtin_amdgcn_mfma_f32_32x32x16_bf16(PAF(2),VFR(2),o[0],0,0,0), C1,0); \
    KRD(GL,3); GAPB(o[1]=__builtin_amdgcn_mfma_f32_32x32x16_bf16(PAF(2),VFR(6),o[1],0,0,0), C1,4); \
    GAPB(o[0]=__builtin_amdgcn_mfma_f32_32x32x16_bf16(PAF(3),VFR(3),o[0],0,0,0), C1,8); \
    GAPB(o[1]=__builtin_amdgcn_mfma_f32_32x32x16_bf16(PAF(3),VFR(7),o[1],0,0,0), C1,12); \
    }while(0)
  int t=1;
  for(;t+(KIND==1?7:5)<NTs;t+=2){
    STEP(pB0,pB1,pA0,pA1,t,true,true,true);     WAIT_BAR(2); RESC(); ROT();
    STEP(pA0,pA1,pB0,pB1,t+1,true,true,true);   WAIT_BAR(2); RESC(); ROT();
  }
  #define ENDW(tt) do{ if((tt)+3<NTs){WAIT_BAR(2);} else if((tt)+2<NTs){WAIT_BAR(1);} else {WAIT_BAR(0);} }while(0)
  for(;t+1<NTs;t+=2){
    STEP(pB0,pB1,pA0,pA1,t,(t+3<NTs),(t+1<NTs),(t+1<NTs));       ENDW(t);   RESC(); ROT();
    STEP(pA0,pA1,pB0,pB1,t+1,(t+4<NTs),(t+2<NTs),(t+2<NTs));     ENDW(t+1); RESC(); ROT();
  }
  STEP(pB0,pB1,pA0,pA1,NTs-1,false,false,false); RESC();
  { float sacc=pB0[0]+pB0[1]; _Pragma("unroll") for(int r=2;r<16;++r)sacc+=pB0[r]; _Pragma("unroll") for(int r=0;r<16;++r)sacc+=pB1[r]; l_reg+=sacc;
    pw0=(u32x4){PKW(pB0,0),PKW(pB0,2),PKW(pB0,4),PKW(pB0,6)};pw1=(u32x4){PKW(pB0,8),PKW(pB0,10),PKW(pB0,12),PKW(pB0,14)};pw2=(u32x4){PKW(pB1,0),PKW(pB1,2),PKW(pB1,4),PKW(pB1,6)};pw3=(u32x4){PKW(pB1,8),PKW(pB1,10),PKW(pB1,12),PKW(pB1,14)};
    SBAR(); pv(o,vb0+sl_cur,PAF(0),PAF(1),PAF(2),PAF(3)); }
  #undef PKW
  #undef PAF
  #undef VFR
  #undef PIN
  #undef MX3
  #undef GAPA
  #undef GAPB
  #undef EX
  #undef VRD
  #undef KRD
  #undef STEP
  #undef ENDW
  {auto rr=__builtin_amdgcn_permlane32_swap(__float_as_uint(l_reg),__float_as_uint(l_reg),false,false);l_reg=__uint_as_float(rr[0])+__uint_as_float(rr[1]);}
  if(hi==0)wsf[32+r32]=l_reg;asm volatile("s_waitcnt lgkmcnt(0)":::"memory");
  float rli[16];
  #pragma unroll
  for(int r=0;r<16;++r)rli[r]=__builtin_amdgcn_rcpf(wsf[32+crow(r,hi)]);
  typedef __attribute__((address_space(3))) int lds_i32; lds_i32* const dstt=(lds_i32*)(shm3+LDS_CB)+wid*32;
  if constexpr(KIND!=0){ if(hi==0){ dstt[r32]=pidx; if(pidx>=0) PL[pidx]=mhat+__builtin_log2f(l_reg); } }
  { bf16*stg=(bf16*)(shm+LDS_OST)+wid*2048;
    #pragma unroll
    for(int r=0;r<16;++r){const int orow=crow(r,hi);
      #pragma unroll
      for(int d0=0;d0<2;++d0)stg[orow*64+d0*32+r32]=__float2bfloat16(o[d0][r]*rli[r]);}
    asm volatile("s_waitcnt lgkmcnt(0)":::"memory");
    #pragma unroll
    for(int i=0;i<4;++i){const int row=i*8+(lane>>3),ch=lane&7; const u32x4 v=*(const u32x4*)(stg+row*64+ch*8);
      if constexpr(KIND==0){ ATTN_STORE16(Odirect+(long)row*DM+ch*8,v); } else { const int d_=dstt[row]; if(d_>=0) ATTN_STORE16(PO+(long)d_*64+ch*8,v); } } }
  asm volatile("s_waitcnt lgkmcnt(0)\n\ts_barrier":::"memory");
  #undef DMA_K
  #undef TI
  #undef DMA_V
  #undef CMASK
  #undef HKA
  #undef START
  #undef RESC
  #undef ROT
}
constexpr int ATTN_LDS_BYTES=LDS_BYTES;
#undef SBAR
#undef WAIT_BAR
}
#include <hip/hip_cooperative_groups.h>
namespace cg = cooperative_groups;
constexpr int NWAVES = 8, M_ROWS = 32768;
constexpr int Bn = 4, S = 8192, D = 1024, FF = 2816, M = Bn * S, PLE = 256, DEPTH = 2;
constexpr float LN_EPS = 1e-5f, DN_ALPHA = 1.4142135623730951f  ;
constexpr size_t MiB = 1u << 20;
constexpr size_t WS_WGU = 2 * MiB, WS_WD = 46 * MiB, WS_WIN = 68 * MiB, WS_WOUT = 74 * MiB, WS_WSIN = 76 * MiB, WS_WSOUT = 80 * MiB, WS_WPG = 82 * MiB, WS_WPP = 86 * MiB;
constexpr size_t WS_WSB = 87 * MiB, WS_WF = 87 * MiB + 256 * 1024, WS_KBAR = 87 * MiB + 512 * 1024, WS_LOGF = 88 * MiB, WS_CB = 89 * MiB, WS_SELM = 90 * MiB;
constexpr size_t WS_PB = 92 * MiB, WS_XB = 124 * MiB, WS_R = 188 * MiB, WS_XB1 = 380 * MiB, WS_PCS = 444 * MiB, WS_PCB = 446 * MiB, WS_SP = 448 * MiB, WS_LST = 454 * MiB, WS_PL = 486 * MiB, WS_WCNT = 490 * MiB, WS_LEN = 491 * MiB, WS_END = 492 * MiB;
constexpr size_t WS_CS = 64 * 1024, WS_LCB = 192 * 1024, WS_CBF = 320 * 1024;
constexpr int PSTR = 18432, CS_WIN = 0, CS_WSIN = 3072, CS_WGU01 = 5120, CS_WGU11 = 10752, CS_WPG0 = 16384, CS_WPG1 = 17408;
constexpr size_t SP_SZ = (size_t)M_ROWS * 4 * 2 * 4;
constexpr size_t SZ_WGU = (size_t)2 * FF * D * 2, SZ_WD = (size_t)D * FF * 2;
constexpr int LDS_BYTES = 147456;
constexpr int HP = 3072;
#define GAS __attribute__((address_space(1)))
#define LAS __attribute__((address_space(3)))
typedef unsigned short bf16;
typedef unsigned v4u __attribute__((ext_vector_type(4)));
typedef unsigned v2u __attribute__((ext_vector_type(2)));
typedef float f32x4 __attribute__((ext_vector_type(4)));
typedef short bf16x8 __attribute__((ext_vector_type(8)));
#define LDS_WAIT() asm volatile("s_waitcnt lgkmcnt(0)" ::: "memory")
__device__ __forceinline__ unsigned f2bf(float f) { unsigned u = __builtin_bit_cast(unsigned, f); return (u + 0x7fffu + ((u >> 16) & 1u)) >> 16; }
__device__ __forceinline__ unsigned pk2(float lo, float hi) { return f2bf(lo) | (f2bf(hi) << 16); }
__device__ __forceinline__ float bflo(unsigned w) { return __uint_as_float(w << 16); }
__device__ __forceinline__ float bfhi(unsigned w) { return __uint_as_float(w & 0xffff0000u); }
__device__ __forceinline__ float wave_sum(float v) {
#pragma unroll
    for (int o = 1; o < 64; o <<= 1) v += __shfl_xor(v, o);
    return v;
}
struct Args { const float* in[20]; float* out; unsigned char* ws; int ph_lo, ph_hi; };

__device__ __forceinline__ void transpose_item(const float* W, int K, int nblk, int ldn, bf16* WT, int mode, LAS float* scr, int item, int lane, const float* lg = nullptr, const float* lb = nullptr, float* pcs = nullptr, float* pcb = nullptr) {
    const int kb = item / nblk, nb = item % nblk, k0 = 64 * kb, n0 = 32 * nb;
    int r0 = n0;
    if (mode == 1) r0 = (n0 >> 7) * 256 + (n0 & 127);
    else if (mode == 2) r0 = (n0 >> 7) * 256 + 128 + (n0 & 127);
    else if (mode == 3) { if (n0 < 1536) r0 = (n0 / 512) * 1024 + (n0 % 512); else { const int n1 = n0 - 1536; r0 = (n1 / 512) * 1024 + 512 + (n1 % 512); } }
#pragma unroll 8
    for (int i = 0; i < 32; ++i) { const int kk = 2 * i + (lane >> 5); scr[kk * 33 + (lane & 31)] = W[(size_t)(k0 + kk) * ldn + n0 + (lane & 31)]; }
    LDS_WAIT(); asm volatile("" ::: "memory");
    const int c = lane & 7;
    f32x4 gq0 = {1.f, 1.f, 1.f, 1.f}, gq1 = {1.f, 1.f, 1.f, 1.f};
    if (lg) { gq0 = *(const f32x4*)(lg + k0 + 8 * c); gq1 = *(const f32x4*)(lg + k0 + 8 * c + 4); }
#pragma unroll
    for (int j = 0; j < 4; ++j) { const int n = (lane >> 3) + 8 * j; const LAS float* s = scr + (8 * c) * 33 + n;
        v4u o; o.x = pk2(s[0 * 33] * gq0[0], s[1 * 33] * gq0[1]); o.y = pk2(s[2 * 33] * gq0[2], s[3 * 33] * gq0[3]); o.z = pk2(s[4 * 33] * gq1[0], s[5 * 33] * gq1[1]); o.w = pk2(s[6 * 33] * gq1[2], s[7 * 33] * gq1[3]);
        if (mode == 4) *(v4u*)(WT + ((size_t)kb * (nblk * 32) + (r0 + n)) * 64 + 8 * c) = o;
        else *(v4u*)(WT + (size_t)(r0 + n) * K + k0 + 8 * c) = o; }
    if (lg) { const int n = lane & 31; float acc = 0.f;
#pragma unroll 8
        for (int kk = 0; kk < 64; ++kk) { const float w = scr[kk * 33 + n]; const float gk = lg[k0 + kk], bk = lb[k0 + kk]; acc += (lane < 32) ? __uint_as_float(f2bf(w * gk) << 16) : w * bk; }
        ((lane < 32) ? pcs : pcb)[(size_t)kb * PSTR + r0 + n] = acc; }
    LDS_WAIT(); asm volatile("" ::: "memory");
}
__device__ __forceinline__ void cvt_copy(const float* src, bf16* dst, size_t n8, size_t gt, size_t ngt) {
    for (size_t i = gt; i < n8; i += ngt) { const f32x4 a = ((const f32x4*)src)[2 * i], b = ((const f32x4*)src)[2 * i + 1];
        v4u o; o.x = pk2(a[0], a[1]); o.y = pk2(a[2], a[3]); o.z = pk2(b[0], b[1]); o.w = pk2(b[2], b[3]); ((v4u*)dst)[i] = o; }
}
__device__ __forceinline__ void p0_prologue(const Args& a, LAS unsigned char* lds, int tid, int lane, int wave) {
    const int BID = lbid(), GRD = lgrid();
    unsigned char* ws = a.ws;
    LAS float* scr = (LAS float*)(lds + wave * 16384);
    const int G = GRD, gw = BID * NWAVES + wave, NGW = G * NWAVES;
    constexpr int I_GU = (D / 64) * (FF / 32), I_D = (FF / 64) * (D / 32), I_IN = (D / 64) * (3072 / 32), I_SQ = (D / 64) * (D / 32), I_SIN = (D / 64) * (2048 / 32), I_PP = (PLE / 64) * (D / 32);
    constexpr int NITEMS = 8 * I_GU + 4 * I_D + I_IN + I_SQ + I_SIN + I_SQ + 2 * I_SQ + 2 * I_PP;
    for (int it = gw; it < NITEMS; it += NGW) {
        int r = it;
        if (r < 8 * I_GU) { const int j = r / I_GU, mat = j >> 1, up = j & 1; r -= j * I_GU;
            const bool ln = (mat & 1); const int li_ = mat >> 1;
            transpose_item((up ? a.in[5] : a.in[4]) + (size_t)mat * D * FF, D, FF / 32, FF, (bf16*)(ws + WS_WGU + (size_t)mat * SZ_WGU), up ? 2 : 1, scr, r, lane,
                           ln ? a.in[2] + (li_ * 3 + 1) * D : nullptr, ln ? a.in[3] + (li_ * 3 + 1) * D : nullptr, (float*)(ws + WS_PCS) + (li_ ? CS_WGU11 : CS_WGU01), (float*)(ws + WS_PCB) + (li_ ? CS_WGU11 : CS_WGU01)); continue; } r -= 8 * I_GU;
        if (r < 4 * I_D) { const int mat = r / I_D; r -= mat * I_D; transpose_item(a.in[6] + (size_t)mat * FF * D, FF, D / 32, D, (bf16*)(ws + WS_WD + (size_t)mat * SZ_WD), 4, scr, r, lane); continue; } r -= 4 * I_D;
        if (r < I_IN) { transpose_item(a.in[7], D, 3072 / 32, 3080, (bf16*)(ws + WS_WIN), 3, scr, r, lane, a.in[2], a.in[3], (float*)(ws + WS_PCS) + CS_WIN, (float*)(ws + WS_PCB) + CS_WIN); continue; } r -= I_IN;
        if (r < I_SQ) { transpose_item(a.in[9], D, D / 32, D, (bf16*)(ws + WS_WOUT), 0, scr, r, lane); continue; } r -= I_SQ;
        if (r < I_SIN) { transpose_item(a.in[11], D, 2048 / 32, 2048, (bf16*)(ws + WS_WSIN), 0, scr, r, lane, a.in[2] + 3 * D, a.in[3] + 3 * D, (float*)(ws + WS_PCS) + CS_WSIN, (float*)(ws + WS_PCB) + CS_WSIN); continue; } r -= I_SIN;
        if (r < I_SQ) { transpose_item(a.in[17], D, D / 32, D, (bf16*)(ws + WS_WSOUT), 0, scr, r, lane); continue; } r -= I_SQ;
        if (r < 2 * I_SQ) { const int mat = r / I_SQ; r -= mat * I_SQ; transpose_item(a.in[19] + (size_t)mat * D * D, D, D / 32, D, (bf16*)(ws + WS_WPG + (size_t)mat * D * D * 2), 0, scr, r, lane, a.in[2] + (mat * 3 + 2) * D, a.in[3] + (mat * 3 + 2) * D, (float*)(ws + WS_PCS) + (mat ? CS_WPG1 : CS_WPG0), (float*)(ws + WS_PCB) + (mat ? CS_WPG1 : CS_WPG0)); continue; } r -= 2 * I_SQ;
        { const int mat = r / I_PP; r -= mat * I_PP; transpose_item(a.in[18] + (size_t)mat * PLE * D, PLE, D / 32, D, (bf16*)(ws + WS_WPP + (size_t)mat * D * PLE * 2), 0, scr, r, lane); }
    }
    const size_t gt = (size_t)BID * 512 + tid, ngt = (size_t)G * 512;
    cvt_copy(a.in[0], (bf16*)(ws + WS_XB), (size_t)M * D / 8, gt, ngt);
    cvt_copy(a.in[1], (bf16*)(ws + WS_PB), (size_t)DEPTH * M * PLE / 8, gt, ngt);
    for (size_t i = gt; i < 8 * 128 * 128; i += ngt) { const int t = (int)(i >> 7) & 127, s = (int)i & 127; ((bf16*)(ws + WS_WSB))[i] = (bf16)(s <= t ? f2bf(a.in[15][i]) : 0u); }
    for (size_t i = gt; i < 8 * 1024; i += ngt) { const int h = (int)(i >> 10), k = (int)i & 1023; ((float*)(ws + WS_WF))[i] = a.in[7][(size_t)k * 3080 + 3072 + h] * a.in[2][k]; }
    for (size_t i = gt; i < 4 * 8 * 32 * 64; i += ngt) ((float*)(ws + WS_KBAR))[i] = 0.f;
    if (BID == 0) for (int i = tid; i < 4096; i += 512) ((unsigned*)ws)[i] = 0u;
}
__device__ __forceinline__ void finalize_cs(const Args& a, int tid, int lane, int wave) {
    const int BID = lbid(), GRD = lgrid();
    unsigned char* ws = a.ws;
    const float* pcs = (const float*)(ws + WS_PCS); const float* pcb = (const float*)(ws + WS_PCB); float* cs = (float*)(ws + WS_CS); float* lcb = (float*)(ws + WS_LCB);
    for (int n = BID * 512 + tid; n < PSTR; n += GRD * 512) { float x = 0.f, y = 0.f;
#pragma unroll
        for (int kb = 0; kb < 16; ++kb) { x += pcs[(size_t)kb * PSTR + n]; y += pcb[(size_t)kb * PSTR + n]; }
        cs[n] = x; lcb[n] = y; }
    if (BID == GRD - 1) { float d = 0.f;
#pragma unroll
        for (int j = 0; j < 16; ++j) { const int k = lane + 64 * j; d += a.in[3][k] * a.in[7][(size_t)k * 3080 + 3072 + wave]; }
        d = wave_sum(d); if (lane == 0) ((float*)(ws + WS_CBF))[wave] = d; }
}
__device__ __forceinline__ void logits_job(const Args& a, const bf16* Z, int lane, int wave) {
    const int BID = lbid(), GRD = lgrid();
    unsigned char* ws = a.ws;
    const float* WF = (const float*)(ws + WS_WF); const float* cbf = (const float*)(ws + WS_CBF); const float* bfp = a.in[8]; float* LOGF = (float*)(ws + WS_LOGF);
    const int gw = BID * NWAVES + wave, NGW = GRD * NWAVES;
    for (int m = gw; m < M; m += NGW) {
        const v2u* xr = (const v2u*)(Z + (size_t)m * D) + lane;
        f32x4 v[4]; float s = 0.f;
#pragma unroll
        for (int j = 0; j < 4; ++j) { const v2u w = xr[64 * j]; v[j] = (f32x4){bflo(w.x), bfhi(w.x), bflo(w.y), bfhi(w.y)}; s += (v[j][0] + v[j][1]) + (v[j][2] + v[j][3]); }
        const float mean = wave_sum(s) * (1.f / D); float s2 = 0.f;
#pragma unroll
        for (int j = 0; j < 4; ++j) { v[j] = v[j] - mean; s2 += (v[j][0] * v[j][0] + v[j][1] * v[j][1]) + (v[j][2] * v[j][2] + v[j][3] * v[j][3]); }
        const float rstd = 1.f / sqrtf(wave_sum(s2) * (1.f / D) + LN_EPS);
        float mine = 0.f;
#pragma unroll
        for (int h = 0; h < 8; ++h) { float d = 0.f;
#pragma unroll
            for (int j = 0; j < 4; ++j) { const f32x4 w = ((const f32x4*)(WF + h * 1024))[64 * j + lane]; d += (v[j][0] * w[0] + v[j][1] * w[1]) + (v[j][2] * w[2] + v[j][3] * w[3]); }
            d = wave_sum(d); if (lane == h) mine = d; }
        if (lane < 8) { const float z = mine * rstd + cbf[lane] + bfp[lane];
            const float e_ = __expf(-fabsf(z)), u_ = 1.f + e_; const float l1p = (u_ == 1.f) ? e_ : __logf(u_) * (e_ / (u_ - 1.f));
            const float ls = fminf(z, 0.f) - l1p;
            const int b = m / S, sidx = m % S; LOGF[((size_t)(b * 8 + lane)) * S + sidx] = ls; }
    }
}
__device__ __forceinline__ void prep_phase(const Args& a, LAS unsigned char* lds, int tid, int lane, int wave) {
    const int BID = lbid(), GRD = lgrid();
    unsigned char* ws = a.ws;
    const float* LOGF = (const float*)(ws + WS_LOGF); float* CB = (float*)(ws + WS_CB);
    if (BID < 32) {
        const float* src = LOGF + (size_t)BID * S + tid * 16; float* dst = CB + (size_t)BID * S + tid * 16;
        float v[16];
#pragma unroll
        for (int j = 0; j < 4; ++j) { const f32x4 x = ((const f32x4*)src)[j]; v[4 * j] = x[0]; v[4 * j + 1] = x[1]; v[4 * j + 2] = x[2]; v[4 * j + 3] = x[3]; }
#pragma unroll
        for (int j = 1; j < 16; ++j) v[j] += v[j - 1];
        float tot = v[15], inc = tot;
#pragma unroll
        for (int o = 1; o < 64; o <<= 1) { const float n = __shfl_up(inc, o); if (lane >= o) inc += n; }
        LAS float* wsum = (LAS float*)lds;
        if (lane == 63) wsum[wave] = inc;
        __syncthreads();
        float base = inc - tot;
        for (int w = 0; w < wave; ++w) base += wsum[w];
#pragma unroll
        for (int j = 0; j < 4; ++j) { f32x4 o; o[0] = -(base + v[4 * j]) * 1.4426950408889634f; o[1] = -(base + v[4 * j + 1]) * 1.4426950408889634f; o[2] = -(base + v[4 * j + 2]) * 1.4426950408889634f; o[3] = -(base + v[4 * j + 3]) * 1.4426950408889634f; ((f32x4*)dst)[j] = o; }
        __syncthreads();
    }
    const bf16* Q = (const bf16*)(ws + WS_R); const float* KBAR = (const float*)(ws + WS_KBAR); unsigned* SELM = (unsigned*)(ws + WS_SELM);
    const int nwv = GRD * NWAVES;
    for (int wv = BID * NWAVES + wave; wv < Bn * 8 * (S / 64); wv += nwv) {
        const int bh = wv / (S / 64), t = (wv % (S / 64)) * 64 + lane; const int b = bh >> 3, h = 8 + (bh & 7);
        const v4u* qp = (const v4u*)(Q + ((size_t)(b * S + t)) * D + h * 64); const v4u* kp = (const v4u*)(Q + (size_t)32 * MiB + ((size_t)(b * S + t)) * D + h * 64);
        float qs = 0.f, ks = 0.f;
#pragma unroll
        for (int c = 0; c < 8; ++c) { const v4u w = qp[c], x = kp[c];
            qs += (bflo(w.x) * bflo(w.x) + bfhi(w.x) * bfhi(w.x)) + (bflo(w.y) * bflo(w.y) + bfhi(w.y) * bfhi(w.y)) + (bflo(w.z) * bflo(w.z) + bfhi(w.z) * bfhi(w.z)) + (bflo(w.w) * bflo(w.w) + bfhi(w.w) * bfhi(w.w));
            ks += (bflo(x.x) * bflo(x.x) + bfhi(x.x) * bfhi(x.x)) + (bflo(x.y) * bflo(x.y) + bfhi(x.y) * bfhi(x.y)) + (bflo(x.z) * bflo(x.z) + bfhi(x.z) * bfhi(x.z)) + (bflo(x.w) * bflo(x.w) + bfhi(x.w) * bfhi(x.w)); }
#pragma unroll
        for (int o = 1; o < 64; o <<= 1) { qs = fmaxf(qs, __shfl_xor(qs, o)); ks = fmaxf(ks, __shfl_xor(ks, o)); }
        if (lane == 0) { atomicMax((unsigned*)ws + 3700 + bh, __float_as_uint(qs)); atomicMax((unsigned*)ws + 3732 + bh, __float_as_uint(ks)); }
    }
    for (int wv = BID * NWAVES + wave; wv < Bn * 8 * (S / 64); wv += nwv) {
        const int bh = __builtin_amdgcn_readfirstlane(wv / (S / 64)), t0 = __builtin_amdgcn_readfirstlane((wv % (S / 64)) * 64);
        const int b = bh >> 3, h = bh & 7, t = t0 + lane, blk = t0 >> 8;
        unsigned mask = 1u << blk;
        if (blk > 0) {
            float q[64];
            const v4u* qp = (const v4u*)(Q + ((size_t)(b * S + t)) * D + h * 64);
#pragma unroll
            for (int c = 0; c < 8; ++c) { const v4u w = qp[c]; q[8 * c] = bflo(w.x); q[8 * c + 1] = bfhi(w.x); q[8 * c + 2] = bflo(w.y); q[8 * c + 3] = bfhi(w.y); q[8 * c + 4] = bflo(w.z); q[8 * c + 5] = bfhi(w.z); q[8 * c + 6] = bflo(w.w); q[8 * c + 7] = bfhi(w.w); }
            float g0 = -3e38f, g1 = -3e38f, g2 = -3e38f; int i0 = -1, i1 = -1, i2 = -1;
            for (int n = 0; n < blk; ++n) {
                const float* kb = KBAR + ((size_t)(bh * 32 + n)) * 64; float gsum = 0.f;
#pragma unroll
                for (int d = 0; d < 64; ++d) gsum += q[d] * kb[d];
                if (gsum > g0) { g2 = g1; i2 = i1; g1 = g0; i1 = i0; g0 = gsum; i0 = n; }
                else if (gsum > g1) { g2 = g1; i2 = i1; g1 = gsum; i1 = n; }
                else if (gsum > g2) { g2 = gsum; i2 = n; }
            }
            if (i0 >= 0) mask |= 1u << i0; if (i1 >= 0) mask |= 1u << i1; if (i2 >= 0) mask |= 1u << i2;
        }
        SELM[(size_t)bh * S + t] = mask;
        unsigned mycnt = 0u;
        for (int n = 0; n < blk; ++n) { const unsigned long long bl = __ballot((mask >> n) & 1u); if (lane == n) mycnt = (unsigned)__popcll(bl); }
        if (lane < 32) ((unsigned*)(ws + WS_WCNT))[((size_t)bh * 128 + (t0 >> 6)) * 32 + lane] = mycnt;
    }
}
__device__ __forceinline__ void lists_phase(const Args& a, int tid, int lane, int wave) {
    const int BID = lbid(), GRD = lgrid();
    unsigned char* ws = a.ws;
    const unsigned* SELM = (const unsigned*)(ws + WS_SELM); const unsigned* WCNT = (const unsigned*)(ws + WS_WCNT); unsigned* LST = (unsigned*)(ws + WS_LST); unsigned* LEN = (unsigned*)(ws + WS_LEN);
    const int nwv = GRD * NWAVES;
    { const int gid = BID * 512 + tid; if (gid < 1024) { const int bh = gid >> 5, qb = gid & 31; const float* cb = (const float*)(ws + WS_CB) + (size_t)bh * S;
        const float B = sqrtf(__uint_as_float(((const unsigned*)ws)[3700 + bh])) * sqrtf(__uint_as_float(((const unsigned*)ws)[3732 + bh])); const float TH = 2.05f * B + 160.f; const float c0 = cb[qb * 256];
        int lo = 0, hi_ = 2 * qb;
        while (lo < hi_) { const int mid = (lo + hi_ + 1) >> 1; if (c0 - cb[128 * mid - 1] >= TH) lo = mid; else hi_ = mid - 1; }
        ((int*)(ws + WS_LEN))[1024 + gid] = 2 * lo; } }
    for (int wv = BID * NWAVES + wave; wv < Bn * 8 * (S / 64); wv += nwv) {
        const int bh = __builtin_amdgcn_readfirstlane(wv / (S / 64)), w = __builtin_amdgcn_readfirstlane(wv % (S / 64));
        const int t = w * 64 + lane, blk = w >> 2;
        unsigned off = 0u;
        { const unsigned* wc_ = WCNT + (size_t)bh * 128 * 32 + (lane & 31); unsigned o0 = 0u, o1 = 0u, o2 = 0u, o3 = 0u; int w2 = 0;
          for (; w2 + 4 <= w; w2 += 4) { o0 += wc_[(w2 + 0) * 32]; o1 += wc_[(w2 + 1) * 32]; o2 += wc_[(w2 + 2) * 32]; o3 += wc_[(w2 + 3) * 32]; }
          for (; w2 < w; ++w2) o0 += wc_[w2 * 32];
          off = (o0 + o1) + (o2 + o3); }
        if (w == 127 && lane < 32) LEN[bh * 32 + lane] = off + WCNT[((size_t)bh * 128 + w) * 32 + lane];
        const unsigned mask = SELM[(size_t)bh * S + t] & ~(1u << blk);
        for (int n = 0; n < blk; ++n) {
            const bool sel = (mask >> n) & 1u; const unsigned long long bl = __ballot(sel);
            const unsigned base = (unsigned)__builtin_amdgcn_readlane((int)off, n);
            if (sel) { const unsigned rank = (unsigned)__popcll(bl & ((1ull << lane) - 1ull)); const unsigned slot = 1u + (unsigned)__popc(mask & ((1u << n) - 1u));
                LST[((size_t)bh * 32 + n) * 8192 + base + rank] = (unsigned)t | (slot << 16); }
        }
    }
}
__device__ __forceinline__ void combine_phase(const Args& a, int tid) {
    const int BID = lbid(), GRD = lgrid();
    unsigned char* ws = a.ws;
    const unsigned* SELM = (const unsigned*)(ws + WS_SELM); const float* PL = (const float*)(ws + WS_PL); const bf16* PO = (const bf16*)a.out; bf16* O = (bf16*)(ws + WS_XB1);
    for (size_t it = (size_t)BID * 512 + tid; it < (size_t)Bn * 8 * S * 8; it += (size_t)GRD * 512) {
        const int c = (int)(it & 7); const size_t row = it >> 3; const int t = (int)(row % S), bh = (int)(row / S), blk = t >> 8;
        const int np = __popc(SELM[row] & ~(1u << blk));
        const f32x4 l4 = *(const f32x4*)(PL + row * 4);
        float m = l4[0]; if (np > 0) m = fmaxf(m, l4[1]); if (np > 1) m = fmaxf(m, l4[2]); if (np > 2) m = fmaxf(m, l4[3]);
        float wsum = 0.f; float acc[8] = {0.f, 0.f, 0.f, 0.f, 0.f, 0.f, 0.f, 0.f};
#pragma unroll
        for (int i = 0; i < 4; ++i) if (i <= np) { const float wgt = __builtin_amdgcn_exp2f(l4[i] - m); wsum += wgt; const v4u p = *(const v4u*)(PO + (row * 4 + i) * 64 + c * 8);
            acc[0] += wgt * bflo(p.x); acc[1] += wgt * bfhi(p.x); acc[2] += wgt * bflo(p.y); acc[3] += wgt * bfhi(p.y); acc[4] += wgt * bflo(p.z); acc[5] += wgt * bfhi(p.z); acc[6] += wgt * bflo(p.w); acc[7] += wgt * bfhi(p.w); }
        const float inv = 1.f / wsum; v4u o; o.x = pk2(acc[0] * inv, acc[1] * inv); o.y = pk2(acc[2] * inv, acc[3] * inv); o.z = pk2(acc[4] * inv, acc[5] * inv); o.w = pk2(acc[6] * inv, acc[7] * inv);
        const int b = bh >> 3, h = bh & 7; *(v4u*)(O + ((size_t)(b * S + t)) * D + h * 64 + c * 8) = o;
    }
}
__device__ __forceinline__ void sgu_mix_phase(const Args& a, LAS unsigned char* lds, int tid, int lane, int wave) {
    const int BID = lbid(), GRD = lgrid();
    unsigned char* ws = a.ws;
    const bf16* U = (const bf16*)(ws + WS_R); const bf16* V = (const bf16*)(ws + WS_R + 64 * MiB); bf16* Y = (bf16*)(ws + WS_R + 128 * MiB);
    const bf16* WSB = (const bf16*)(ws + WS_WSB); const float* bs = a.in[16]; const float* lng = a.in[13]; const float* lnb = a.in[14];
    LAS float* stat = (LAS float*)lds;
    LAS bf16* vnT = (LAS bf16*)(lds + 1024);
    constexpr int VP = 136;
    for (int chunk = BID; chunk < M / 128; chunk += GRD) {
        const size_t R0 = (size_t)chunk * 128;
#pragma unroll
        for (int bt = 0; bt < 2; ++bt) { v4u w0[8], w1[8];
#pragma unroll
            for (int i = 0; i < 8; ++i) { const v4u* vp = (const v4u*)(V + (R0 + wave * 16 + bt * 8 + i) * D + lane * 16); w0[i] = vp[0]; w1[i] = vp[1]; }
            float q1[8], q2[8];
#pragma unroll
            for (int i = 0; i < 8; ++i) { const float x0 = bflo(w0[i].x), x1 = bfhi(w0[i].x), x2 = bflo(w0[i].y), x3 = bfhi(w0[i].y), x4 = bflo(w0[i].z), x5 = bfhi(w0[i].z), x6 = bflo(w0[i].w), x7 = bfhi(w0[i].w);
                const float y0 = bflo(w1[i].x), y1 = bfhi(w1[i].x), y2 = bflo(w1[i].y), y3 = bfhi(w1[i].y), y4 = bflo(w1[i].z), y5 = bfhi(w1[i].z), y6 = bflo(w1[i].w), y7 = bfhi(w1[i].w);
                q1[i] = (((x0 + x1) + (x2 + x3)) + ((x4 + x5) + (x6 + x7))) + (((y0 + y1) + (y2 + y3)) + ((y4 + y5) + (y6 + y7)));
                q2[i] = (((x0 * x0 + x1 * x1) + (x2 * x2 + x3 * x3)) + ((x4 * x4 + x5 * x5) + (x6 * x6 + x7 * x7))) + (((y0 * y0 + y1 * y1) + (y2 * y2 + y3 * y3)) + ((y4 * y4 + y5 * y5) + (y6 * y6 + y7 * y7))); }
#pragma unroll
            for (int o = 1; o < 64; o <<= 1)
#pragma unroll
                for (int i = 0; i < 8; ++i) { q1[i] += __shfl_xor(q1[i], o); q2[i] += __shfl_xor(q2[i], o); }
            if (lane == 0) {
#pragma unroll
                for (int i = 0; i < 8; ++i) { const float mean = q1[i] * (1.f / D); const float var = q2[i] * (1.f / D) - mean * mean; const int r = wave * 16 + bt * 8 + i; stat[2 * r] = mean; stat[2 * r + 1] = 1.f / sqrtf(fmaxf(var, 0.f) + LN_EPS); } } }
        __syncthreads();
        for (int g = 0; g < 8; ++g) {
#pragma unroll
            for (int it = 0; it < 4; ++it) { const int idx = it * 512 + tid, s = idx & 127, dc = idx >> 7;
                const v4u w = *(const v4u*)(V + (R0 + s) * D + g * 128 + dc * 8);
                const float mean = stat[2 * s], rstd = stat[2 * s + 1];
                const f32x4 g0 = *(const f32x4*)(lng + g * 128 + dc * 8), g1 = *(const f32x4*)(lng + g * 128 + dc * 8 + 4), b0 = *(const f32x4*)(lnb + g * 128 + dc * 8), b1 = *(const f32x4*)(lnb + g * 128 + dc * 8 + 4);
                LAS bf16* o = vnT + (dc * 8) * VP + s;
                o[0 * VP] = (bf16)f2bf((bflo(w.x) - mean) * rstd * g0[0] + b0[0]); o[1 * VP] = (bf16)f2bf((bfhi(w.x) - mean) * rstd * g0[1] + b0[1]);
                o[2 * VP] = (bf16)f2bf((bflo(w.y) - mean) * rstd * g0[2] + b0[2]); o[3 * VP] = (bf16)f2bf((bfhi(w.y) - mean) * rstd * g0[3] + b0[3]);
                o[4 * VP] = (bf16)f2bf((bflo(w.z) - mean) * rstd * g1[0] + b1[0]); o[5 * VP] = (bf16)f2bf((bfhi(w.z) - mean) * rstd * g1[1] + b1[1]);
                o[6 * VP] = (bf16)f2bf((bflo(w.w) - mean) * rstd * g1[2] + b1[2]); o[7 * VP] = (bf16)f2bf((bfhi(w.w) - mean) * rstd * g1[3] + b1[3]); }
            __syncthreads();
            const int t0 = wave * 16, nks = (t0 + 15) / 32 + 1, fr = lane & 15, fq = lane >> 4;
            bf16x8 wf[4];
#pragma unroll
            for (int ks = 0; ks < 4; ++ks) wf[ks] = (ks < nks) ? *(const bf16x8*)(WSB + ((size_t)g * 128 + t0 + fr) * 128 + ks * 32 + fq * 8) : (bf16x8){0, 0, 0, 0, 0, 0, 0, 0};
            const float bst = bs[g * 128 + t0 + fr];
#pragma unroll
            for (int dt = 0; dt < 8; ++dt) { f32x4 acc = {0.f, 0.f, 0.f, 0.f};
#pragma unroll
                for (int ks = 0; ks < 4; ++ks) if (ks < nks) { const bf16x8 af = *(const LAS bf16x8*)(vnT + (dt * 16 + fr) * VP + ks * 32 + fq * 8); acc = __builtin_amdgcn_mfma_f32_16x16x32_bf16(af, wf[ks], acc, 0, 0, 0); }
                const size_t off = (R0 + t0 + fr) * D + g * 128 + dt * 16 + fq * 4;
                const v2u uw = *(const v2u*)(U + off); v2u o;
                o.x = pk2(bflo(uw.x) * (acc[0] + bst), bfhi(uw.x) * (acc[1] + bst)); o.y = pk2(bflo(uw.y) * (acc[2] + bst), bfhi(uw.y) * (acc[3] + bst));
                *(v2u*)(Y + off) = o; }
            __syncthreads();
        }
    }
}
#ifndef EXP
#define EXP 0
#endif
__device__ __forceinline__ void attn_phase(const Args& a, unsigned char* lds_generic) {
    const int BID = lbid(), GRD = lgrid();
    unsigned char* ws = a.ws;
    const attn_body::bf16* Q = (const attn_body::bf16*)(ws + WS_R); const attn_body::bf16* K = (const attn_body::bf16*)(ws + WS_R + 64 * MiB); const attn_body::bf16* V = (const attn_body::bf16*)(ws + WS_R + 128 * MiB);
    attn_body::bf16* O = (attn_body::bf16*)(ws + WS_XB1); attn_body::bf16* PO = (attn_body::bf16*)a.out; float* PL = (float*)(ws + WS_PL);
    const float* CB = (const float*)(ws + WS_CB); const unsigned* LST = (const unsigned*)(ws + WS_LST); const unsigned* LEN = (const unsigned*)(ws + WS_LEN);
    int tid = threadIdx.x; asm volatile("" : "+v"(tid)); const int lane = tid & 63, r32 = lane & 31; const int wid = __builtin_amdgcn_readfirstlane(tid >> 6);
    const int G = GRD, bx = BID; const int vcu = (G % 8 == 0) ? (bx % 8) * (G / 8) + bx / 8 : bx;
    constexpr int DMh = attn_body::DM;
    typedef __attribute__((address_space(3))) int lds_int;
    lds_int* offs = (lds_int*)((__attribute__((address_space(3))) unsigned char*)lds_generic + attn_body::LDS_BYTES);
    lds_int* wtot = offs + 1032;
    { const int c0 = (int)((LEN[2 * tid] + 255u) >> 8), c1 = (int)((LEN[2 * tid + 1] + 255u) >> 8); const int mine = c0 + c1; int inc = mine;
#pragma unroll
      for (int o = 1; o < 64; o <<= 1) { const int n = __shfl_up(inc, o); if (lane >= o) inc += n; }
      if (lane == 63) wtot[wid] = inc;
      __syncthreads();
      int base = inc - mine; for (int w = 0; w < wid; ++w) base += wtot[w];
      offs[2 * tid] = base; offs[2 * tid + 1] = base + c0; if (tid == 511) offs[1024] = base + mine;
      __syncthreads(); }
    const int nsel = offs[1024], FOXN = (EXP == 10 ? 2048 : 1024), total = FOXN + 1024 + nsel;
    const int* TMIN = (const int*)(ws + WS_LEN) + 1024; unsigned* qctr = (unsigned*)ws + 3600;
    for (;;) {
        int qo_ = 1048; asm volatile("" : "+s"(qo_)); lds_int* qslot = offs + qo_;
        int tl_ = tid; asm volatile("" : "+v"(tl_)); const int r32 = tl_ & 31; const int wid = __builtin_amdgcn_readfirstlane(tl_ >> 6);
        if (tid == 0) qslot[0] = (int)__hip_atomic_fetch_add(qctr, 1u, __ATOMIC_RELAXED, __HIP_MEMORY_SCOPE_AGENT);
        __syncthreads();
        const int idx = qslot[0];
        if (idx >= total) break;
        if (idx < FOXN) {
            const int qb = 31 - ((idx & 1023) >> 5), bh8 = idx & 31; const int b = bh8 >> 3, h = 8 + (bh8 & 7); const size_t rowbase = (size_t)b * S; const int q0 = qb * 256;
            const int NT = 4 * qb + 4, NTs = NT - TMIN[bh8 * 32 + qb];
            attn_body::attn_unit<8, 0>(Q + (rowbase + q0 + wid * 32 + r32) * DMh + h * 64, K + rowbase * DMh + h * 64, V + rowbase * DMh + h * 64, NT, NTs, (char*)lds_generic,
                                       CB + (size_t)bh8 * S, 0u, nullptr, h, O + (rowbase + q0 + wid * 32) * DMh + h * 64, -1, nullptr, nullptr, 0);
        } else if (idx < FOXN + nsel) {
            const int u = idx - FOXN; int lo = 0, hi_ = 1023;
            while (lo < hi_) { const int mid = (lo + hi_ + 1) >> 1; if (offs[mid] <= u) lo = mid; else hi_ = mid - 1; }
            const int li = lo, c = u - offs[li]; const int bh8 = li >> 5, n = li & 31; const int b = bh8 >> 3, h = bh8 & 7; const size_t rowbase = (size_t)b * S;
            const int len = (int)LEN[li]; const int e = c * 256 + wid * 32 + r32; const bool valid = e < len;
            const unsigned ent = LST[(size_t)li * 8192 + (valid ? e : 0)]; const int t = (int)(ent & 0xffffu), slot = (int)(ent >> 16);
            attn_body::attn_unit<8, 2>(Q + (rowbase + t) * DMh + h * 64, K + (rowbase + n * 256) * DMh + h * 64, V + (rowbase + n * 256) * DMh + h * 64, 4, 4, (char*)lds_generic,
                                       nullptr, 0u, a.in[10], h, nullptr, valid ? (int)(((size_t)bh8 * S + t) * 4 + slot) : -1, PO, PL, t - n * 256);
        } else {
            const int u = idx - FOXN - nsel; const int bh8 = u >> 5, blk = u & 31; const int b = bh8 >> 3, h = bh8 & 7; const size_t rowbase = (size_t)b * S; const int t = blk * 256 + wid * 32 + r32;
            attn_body::attn_unit<8, 1>(Q + (rowbase + t) * DMh + h * 64, K + (rowbase + blk * 256) * DMh + h * 64, V + (rowbase + blk * 256) * DMh + h * 64, 4, 4, (char*)lds_generic,
                                       nullptr, 1u, a.in[10], h, nullptr, (int)(((size_t)bh8 * S + t) * 4), PO, PL, 0);
        }
    }
}

#define XB_TMO      128
#define XB_XCNT(j)  (256  + 64 * (j))
#define XB_XSUB(j)  (1280 + 64 * (j))
#define XB_XGEN(j)  (2304 + 64 * (j))
#define XB_TOP      3328
#define XB_TOPGEN   3392
#define XCD_BAR_WORDS 3456
#define XB_SPIN_CAP (1u << 18)

__device__ __forceinline__ unsigned xb_ld(unsigned* p)              { return __hip_atomic_load(p, __ATOMIC_RELAXED, __HIP_MEMORY_SCOPE_AGENT); }
__device__ __forceinline__ unsigned xb_add(unsigned* p, unsigned v) { return __hip_atomic_fetch_add(p, v, __ATOMIC_RELAXED, __HIP_MEMORY_SCOPE_AGENT); }
__device__ __forceinline__ unsigned xb_xcc_id() { return (unsigned)__builtin_amdgcn_s_getreg((3 << 11) | 20) & 0xFu; }
#define XB_SPIN(cond, bar) do { unsigned _sp = 0; while (cond) { __builtin_amdgcn_s_sleep(1); \
    if ((++_sp & 255u) == 0u) { if (xb_ld(&(bar)[XB_TMO])) break; if (_sp > XB_SPIN_CAP) { atomicAdd(&(bar)[XB_TMO], 1u); break; } } } } while (0)

struct XcdBarrier {
    unsigned* bar; unsigned x;
    volatile LAS unsigned* st;
};

__device__ __forceinline__ XcdBarrier xcd_barrier_post(unsigned* bar, volatile LAS unsigned* st) {
    XcdBarrier b; b.bar = bar; b.x = xb_xcc_id(); b.st = st;
    if (threadIdx.x == 0) (void)xb_add(&bar[XB_XCNT(b.x)], 1u);
    return b;
}
__device__ __forceinline__ void xcd_barrier_complete(unsigned* bar, unsigned x, unsigned& nloc, unsigned& nx) {
    const unsigned G = gridDim.x * gridDim.y * gridDim.z;
    unsigned sum, cnt, mine, sp = 0u;
    for (;;) {
        sum = 0u; cnt = 0u; mine = 0u;
#pragma unroll
        for (unsigned j = 0; j < 16; ++j) { const unsigned c = xb_ld(&bar[XB_XCNT(j)]); sum += c; cnt += (c > 0u) ? 1u : 0u; mine = (j == x) ? c : mine; }
        if (sum == G) break;
        __builtin_amdgcn_s_sleep(1);
        if ((++sp & 255u) == 0u) { if (xb_ld(&bar[XB_TMO])) break; if (sp > XB_SPIN_CAP) { atomicAdd(&bar[XB_TMO], 1u); break; } }
    }
    nloc = mine > 0u ? mine : 1u; nx = cnt > 0u ? cnt : 1u;
}

__device__ __forceinline__ void xcd_barrier(const XcdBarrier& b) {
    asm volatile("s_waitcnt vmcnt(0)" ::: "memory");
    __syncthreads();
    if (threadIdx.x == 0) {
        unsigned* bar = b.bar;
        __builtin_amdgcn_s_waitcnt(0);
        unsigned nloc = b.st[0], nx = b.st[1];
        if (nloc == 0u) { xcd_barrier_complete(bar, b.x, nloc, nx); b.st[0] = nloc; b.st[1] = nx; }
        const unsigned old = xb_add(&bar[XB_XSUB(b.x)], 1u);
        const unsigned gen = old / nloc;
        if (old + 1u == (gen + 1u) * nloc) {
            __builtin_amdgcn_fence(__ATOMIC_RELEASE, "agent");
            asm volatile("s_waitcnt vmcnt(0)" ::: "memory");
            const unsigned og = xb_add(&bar[XB_TOP], 1u);
            const unsigned tg = og / nx;
            if (og + 1u == (tg + 1u) * nx) xb_add(&bar[XB_TOPGEN], 1u);
            else XB_SPIN(xb_ld(&bar[XB_TOPGEN]) == tg, bar);
            __builtin_amdgcn_fence(__ATOMIC_ACQUIRE, "agent");
            xb_add(&bar[XB_XGEN(b.x)], 1u);
            asm volatile("s_waitcnt vmcnt(0)" ::: "memory");
        } else {
            XB_SPIN(xb_ld(&bar[XB_XGEN(b.x)]) == gen, bar);
            __builtin_amdgcn_fence(__ATOMIC_ACQUIRE, "agent");
            asm volatile("s_waitcnt vmcnt(0)" ::: "memory");
        }
    }
    __syncthreads();
}

__global__ void __launch_bounds__(NWAVES * 64, 2) mega_fwd(Args a0) {
    extern __shared__ __attribute__((aligned(16))) unsigned char lds[];
    LAS unsigned char* L = (LAS unsigned char*)lds;
    const int tid = threadIdx.x, lane = tid & 63, wave = __builtin_amdgcn_readfirstlane(tid >> 6);
    cg::grid_group grid = cg::this_grid();
    volatile LAS unsigned* MISC = (volatile LAS unsigned*)(L + 131072);
    if (threadIdx.x < 16) MISC[threadIdx.x] = 0u;
    __syncthreads();
    unsigned* const barw = (unsigned*)a0.ws;
    XcdBarrier bar; bar.bar = barw; bar.x = 0; bar.st = nullptr;
    int ph = 0; const int ph_lo = a0.ph_lo, ph_hi = a0.ph_hi;
#define PHASE_BEGIN if (ph >= ph_lo && ph < ph_hi) { int tid = threadIdx.x; asm volatile("" : "+v"(tid)); const int lane = tid & 63, wave = __builtin_amdgcn_readfirstlane(tid >> 6); (void)lane; (void)wave; const int BID = lbid(), G = lgrid(); (void)BID; (void)G; \
    const __attribute__((address_space(4))) Args* kp_ = (const __attribute__((address_space(4))) Args*)__builtin_amdgcn_kernarg_segment_ptr(); asm volatile("" : "+s"(kp_)); Args a; _Pragma("unroll") for (int i_ = 0; i_ < 20; ++i_) a.in[i_] = kp_->in[i_]; a.out = kp_->out; a.ws = kp_->ws; a.ph_lo = 0; a.ph_hi = 0; \
    unsigned char* ws = a.ws; float* XF = a.out; bf16* XB = (bf16*)(ws + WS_XB); bf16* XB1 = (bf16*)(ws + WS_XB1); bf16* R = (bf16*)(ws + WS_R); LAS unsigned char* XL = L + 131072 + 1024; (void)XF; (void)XB; (void)XB1; (void)R; (void)XL; \
    const float* CSV = (const float*)(ws + WS_CS); const float* LCB = (const float*)(ws + WS_LCB); (void)CSV; (void)LCB;
#define PHASE_END if (ph + 1 < ph_hi) { if (ph == 0) { grid.sync(); bar = xcd_barrier_post(barw, MISC + 8); } else xcd_barrier(bar); } } ++ph;
#define SPI(k) ((float*)(ws + WS_SP + (size_t)(k) * SP_SZ))
#define LNG(li, k) (a.in[2] + ((li) * 3 + (k)) * D)
#define LNB(li, k) (a.in[3] + ((li) * 3 + (k)) * D)
#define GEMM_RUN(EPI, Aptr, Bptr, N_, K_, ...) GEMM_RUN_X(EPI, Aptr, Bptr, N_, K_, K_, K_, 128L, 128L, __VA_ARGS__)
#define GEMM_RUN_LD(EPI, Aptr, Bptr, N_, K_, LDA_, LDB_, ...) GEMM_RUN_X(EPI, Aptr, Bptr, N_, K_, 64, 64, (long)M * 128L, (long)(N_) * 128L, __VA_ARGS__)
#define GEMM_RUN_X(EPI, Aptr, Bptr, N_, K_, LDA_, LDB_, KSA_, KSB_, ...) { pg8::Gemm g{(const bf16*)(Aptr), (const bf16*)(Bptr), M, (N_), (K_), (LDA_), (LDB_), (KSA_), (KSB_)}; pg8::StaticOrder so; so.init(M, (N_), G, BID); EPI E{__VA_ARGS__}; pg8::gemm_phase<EPI, pg8::StaticOrder, true, true>(L, g, so, E); }
#define FFN_UP(LNFLAG, Aptr, mat, spk, csoff) GEMM_RUN(pg8::EpiSwiglu<LNFLAG>, Aptr, ws + WS_WGU + (size_t)(mat) * SZ_WGU, 2 * FF, D, R, M, SPI(spk), CSV + (csoff), LCB + (csoff))
#ifndef EXP
#define EXP 0
#endif
#define REPEAT_IF(c) for (int rep_ = 0; rep_ < ((c) ? 2 : 1); ++rep_)
    PHASE_BEGIN p0_prologue(a, L, tid, lane, wave); PHASE_END
    if (EXP == 4) { for (int i_ = 0; i_ < 50; ++i_) xcd_barrier(bar); }
    PHASE_BEGIN finalize_cs(a, tid, lane, wave); FFN_UP(false, XB, 0, 0, 0) PHASE_END
    REPEAT_IF(EXP == 7) { if (rep_) --ph; PHASE_BEGIN GEMM_RUN_LD(pg8::EpiResid<0>, R, ws + WS_WD + 0 * SZ_WD, D, FF, HP, FF, a.in[0], nullptr, XB, DN_ALPHA, 0.5f, nullptr, nullptr, nullptr, SPI(0), XL) PHASE_END }
    if (EXP == 20) { --ph; PHASE_BEGIN GEMM_RUN_LD(pg8::EpiBf16<0>, R, ws + WS_WD + 0 * SZ_WD, D, FF, HP, FF, XB1, D, nullptr, 0, 0, 1.f) PHASE_END }
    if (EXP == 21) { --ph; PHASE_BEGIN GEMM_RUN(pg8::EpiBf16<0>, XB, ws + WS_WOUT, D, D, XB1, D, nullptr, 0, 0, 1.f) PHASE_END }
    REPEAT_IF(EXP == 8) { if (rep_) --ph; PHASE_BEGIN logits_job(a, XB, lane, wave);
        GEMM_RUN(pg8::EpiQKV, XB, ws + WS_WIN, 3072, D, R, (size_t)(64 * MiB) / 2, attn_body::C2, (float*)(ws + WS_KBAR), SPI(0), CSV + CS_WIN, LCB + CS_WIN) PHASE_END }
    PHASE_BEGIN prep_phase(a, L, tid, lane, wave); PHASE_END
    REPEAT_IF(EXP == 13) { if (rep_) --ph; PHASE_BEGIN lists_phase(a, tid, lane, wave); PHASE_END }
    PHASE_BEGIN attn_phase(a, lds); PHASE_END
    REPEAT_IF(EXP == 14) { if (rep_) --ph; PHASE_BEGIN combine_phase(a, tid); PHASE_END }
    PHASE_BEGIN GEMM_RUN(pg8::EpiResid<1>, XB1, ws + WS_WOUT, D, D, nullptr, XB, XB, DN_ALPHA, 1.0f, SPI(0), LNG(0, 0), LNB(0, 0), SPI(1), XL) PHASE_END
    PHASE_BEGIN FFN_UP(true, XB, 1, 1, CS_WGU01) PHASE_END
    PHASE_BEGIN GEMM_RUN(pg8::EpiBf16<0>, ws + WS_PB, ws + WS_WPP, D, PLE, XB1, D, nullptr, 0, 0, 1.f)
        GEMM_RUN_LD(pg8::EpiResid<1>, R, ws + WS_WD + 1 * SZ_WD, D, FF, HP, FF, nullptr, XB, XB, DN_ALPHA, 0.5f, SPI(1), LNG(0, 1), LNB(0, 1), SPI(2), XL) PHASE_END
    PHASE_BEGIN GEMM_RUN(pg8::EpiPle<false>, XB, ws + WS_WPG, D, D, XB, nullptr, XB1, SPI(2), CSV + CS_WPG0, LCB + CS_WPG0, LNG(0, 2), LNB(0, 2)) PHASE_END
    PHASE_BEGIN FFN_UP(false, XB1, 2, 0, 0) PHASE_END
    PHASE_BEGIN GEMM_RUN_LD(pg8::EpiResid<2>, R, ws + WS_WD + 2 * SZ_WD, D, FF, HP, FF, nullptr, XB1, XB, DN_ALPHA, 0.5f, nullptr, nullptr, nullptr, SPI(3), XL) PHASE_END
    PHASE_BEGIN GEMM_RUN(pg8::EpiSguIn, XB, ws + WS_WSIN, 2048, D, R, (bf16*)(ws + WS_R + 64 * MiB), a.in[12], SPI(3), CSV + CS_WSIN, LCB + CS_WSIN, nullptr, XL) PHASE_END
    REPEAT_IF(EXP == 6) { if (rep_) --ph; PHASE_BEGIN sgu_mix_phase(a, L, tid, lane, wave); PHASE_END }
    PHASE_BEGIN GEMM_RUN(pg8::EpiResid<1>, ws + WS_R + 128 * MiB, ws + WS_WSOUT, D, D, nullptr, XB, XB, DN_ALPHA, 1.0f, SPI(3), LNG(1, 0), LNB(1, 0), SPI(4), XL) PHASE_END
    PHASE_BEGIN FFN_UP(true, XB, 3, 4, CS_WGU11) PHASE_END
    PHASE_BEGIN GEMM_RUN(pg8::EpiBf16<0>, ws + WS_PB + (size_t)M * PLE * 2, ws + WS_WPP + (size_t)D * PLE * 2, D, PLE, XB1, D, nullptr, 0, 0, 1.f)
        GEMM_RUN_LD(pg8::EpiResid<1>, R, ws + WS_WD + 3 * SZ_WD, D, FF, HP, FF, nullptr, XB, XB, DN_ALPHA, 0.5f, SPI(4), LNG(1, 1), LNB(1, 1), SPI(5), XL) PHASE_END
    PHASE_BEGIN GEMM_RUN(pg8::EpiPle<true>, XB, ws + WS_WPG + (size_t)D * D * 2, D, D, XB, XF, XB1, SPI(5), CSV + CS_WPG1, LCB + CS_WPG1, LNG(1, 2), LNB(1, 2)) PHASE_END
#undef PHASE_BEGIN
#undef PHASE_END
}
constexpr int N_PHASES = 20;

#ifndef MK_PER_PHASE
#define MK_PER_PHASE 0
#endif
extern "C" void kernel_launch(void* const* d_in, const int* in_sizes, int n_in, void* d_out, int out_size, void* d_ws, size_t ws_size, hipStream_t stream) {
    static int grid = 0;
    if (grid == 0) {
        if (n_in != 20 || out_size != M * D || ws_size < WS_END) { fprintf(stderr, "kernel_launch: unexpected shapes (n_in %d out %d ws %zu)\n", n_in, out_size, ws_size); grid = -1; return; }
        int dev = 0, cus = 0, per_cu = 0;
        hipGetDevice(&dev); hipDeviceGetAttribute(&cus, hipDeviceAttributeMultiprocessorCount, dev);
        if (hipFuncSetAttribute((const void*)mega_fwd, hipFuncAttributeMaxDynamicSharedMemorySize, LDS_BYTES) != hipSuccess) { fprintf(stderr, "kernel_launch: hipFuncSetAttribute failed\n"); grid = -1; return; }
        if (hipOccupancyMaxActiveBlocksPerMultiprocessor(&per_cu, (const void*)mega_fwd, NWAVES * 64, LDS_BYTES) != hipSuccess || per_cu < 1) { fprintf(stderr, "kernel_launch: occupancy query says %d\n", per_cu); per_cu = 1; }
        (void)hipGetLastError();
        grid = cus * per_cu;
        fprintf(stderr, "kernel_launch: grid %d (cus %d x %d)\n", grid, cus, per_cu);
    }
    if (grid < 0) return;
    Args a{};
    for (int i = 0; i < 20; ++i) a.in[i] = (const float*)d_in[i];
    a.out = (float*)d_out; a.ws = (unsigned char*)d_ws;
#if MK_PER_PHASE
    for (int p = 0; p < N_PHASES; ++p) { a.ph_lo = p; a.ph_hi = p + 1; hipLaunchKernelGGL(mega_fwd, dim3(grid), dim3(NWAVES * 64), LDS_BYTES, stream, a); }
#else
    a.ph_lo = 0; a.ph_hi = N_PHASES;
    void* args[] = {&a};
    hipError_t e = hipLaunchCooperativeKernel((const void*)mega_fwd, dim3(grid), dim3(NWAVES * 64), args, LDS_BYTES, stream);
    if (e != hipSuccess) fprintf(stderr, "cooperative launch failed: %s (grid %d)\n", hipGetErrorString(e), grid);
#endif
}
```
